# Optimizing an MI355X kernel written in HIP

```python
import jax, jax.numpy as jnp
from jax import lax
import numpy as np

D_MODEL = 1024
BATCH = 8
SEQ = 2048
DEPTH = 2

PLE_DIM = 256
EPS = 1e-6
A_HEAD_DIM = 128
A_HEADS = (D_MODEL // 2) // A_HEAD_DIM
A_DIM = A_HEADS * A_HEAD_DIM
QKV_CONV_WIDTH = 4
CHUNK = 64
POOL_WINDOWS = (2, 4, 8, 16)
POOL_GROUPS = len(POOL_WINDOWS)
POOL_DIM = D_MODEL // 4
POOL_GROUP_DIM = POOL_DIM // POOL_GROUPS
CONV_HEADS = 4
CONV_DIM = D_MODEL // 4
CONV_WIDTH = 3
D_MIX = A_DIM + POOL_DIM + CONV_DIM
IN_SIZES = (A_DIM, A_DIM, A_DIM, A_DIM, A_HEADS, A_HEADS, POOL_DIM, CONV_DIM, CONV_DIM, CONV_DIM)
D_IN = sum(IN_SIZES)
D_FF = -(-8 * D_MODEL // (3 * 256)) * 256

kernel_name = 'hybrid_parallel_deltanet_pool_shortconv'


def rms_norm(x, g):
    xf = x.astype(jnp.float32)
    y = xf * lax.rsqrt(jnp.mean(xf * xf, axis=-1, keepdims=True) + EPS)
    return (y * g.astype(jnp.float32)).astype(x.dtype)


def causal_dwconv(x, w):
    K, C = w.shape
    return lax.conv_general_dilated(
        x, w[:, None, :].astype(x.dtype), window_strides=(1,), padding=[(K - 1, 0)],
        dimension_numbers=('NWC', 'WIO', 'NWC'), feature_group_count=C)


def l2norm(t):
    return t * lax.rsqrt(jnp.sum(t * t, axis=-1, keepdims=True) + EPS)


def chunk_gated_delta_rule(q, k, v, g, beta):
    Bn, S, H, DK = q.shape
    DV = v.shape[-1]
    N = S // CHUNK

    def to_chunks(t):
        t = t.reshape((Bn, N, CHUNK, H) + t.shape[3:])
        return jnp.moveaxis(t, 3, 1)

    q = to_chunks(q * (DK ** -0.5))
    k = to_chunks(k)
    v = to_chunks(v)
    g = to_chunks(g)
    beta = to_chunks(beta)
    gc = jnp.cumsum(g, axis=-1)
    kb = k * beta[..., None]
    vb = v * beta[..., None]
    causal_incl = jnp.tril(jnp.ones((CHUNK, CHUNK), dtype=bool))
    causal_strict = jnp.tril(jnp.ones((CHUNK, CHUNK), dtype=bool), -1)
    diff = gc[..., :, None] - gc[..., None, :]
    decay = jnp.exp(jnp.where(causal_incl, diff, -jnp.inf))
    lower = jnp.where(causal_strict, jnp.einsum('bhncd,bhnsd->bhncs', kb, k) * decay, 0.0)
    eye = jnp.eye(CHUNK, dtype=jnp.float32)
    tmat = lax.linalg.triangular_solve(eye + lower, jnp.broadcast_to(eye, lower.shape),
                                       left_side=True, lower=True, unit_diagonal=True)
    u = jnp.einsum('bhncs,bhnsv->bhncv', tmat, vb)
    w = jnp.einsum('bhncs,bhnsd->bhncd', tmat, kb * jnp.exp(gc)[..., None])
    attn = jnp.einsum('bhncd,bhnsd->bhncs', q, k) * decay

    def step(state, inp):
        q_i, k_i, u_i, w_i, gc_i, a_i = inp
        v_new = u_i - jnp.einsum('bhck,bhkv->bhcv', w_i, state)
        o_i = (jnp.einsum('bhck,bhkv->bhcv', q_i * jnp.exp(gc_i)[..., None], state)
               + jnp.einsum('bhcs,bhsv->bhcv', a_i, v_new))
        g_last = gc_i[..., -1]
        state = (state * jnp.exp(g_last)[..., None, None]
                 + jnp.einsum('bhck,bhcv->bhkv', k_i * jnp.exp(g_last[..., None] - gc_i)[..., None], v_new))
        return state, o_i

    xs = tuple(jnp.moveaxis(t, 2, 0) for t in (q, k, u, w, gc, attn))
    state0 = jnp.zeros((Bn, H, DK, DV), jnp.float32)
    _, o = lax.scan(step, state0, xs)
    return jnp.transpose(o, (1, 0, 3, 2, 4)).reshape(Bn, S, H, DV)


def gated_deltanet(q, k, v, z, a, b, conv_w, a_log, dt_bias, onorm_g):
    Bn, S, _ = q.shape
    qkv = jax.nn.silu(causal_dwconv(jnp.concatenate([q, k, v], axis=-1), conv_w))
    q, k, v = jnp.split(qkv.astype(jnp.float32), 3, axis=-1)
    hs = (Bn, S, A_HEADS, A_HEAD_DIM)
    q = l2norm(q.reshape(hs))
    k = l2norm(k.reshape(hs))
    v = v.reshape(hs)
    beta = jax.nn.sigmoid(b.astype(jnp.float32))
    g = -jnp.exp(a_log.astype(jnp.float32)) * jax.nn.softplus(a.astype(jnp.float32) + dt_bias.astype(jnp.float32))
    o = chunk_gated_delta_rule(q, k, v, g, beta)
    o = o * lax.rsqrt(jnp.mean(o * o, axis=-1, keepdims=True) + EPS) * onorm_g.astype(jnp.float32)
    o = o * jax.nn.silu(z.astype(jnp.float32).reshape(hs))
    return o.reshape(Bn, S, A_DIM).astype(z.dtype)


def multiscale_pool(h, pool_w, pool_scale):
    Bn, S, _ = h.shape
    hf = h.astype(jnp.float32)
    cs = jnp.cumsum(hf, axis=1)
    count = jnp.arange(1, S + 1, dtype=jnp.float32)[:, None]
    outs = []
    for gi, win in enumerate(POOL_WINDOWS):
        sl = slice(gi * POOL_GROUP_DIM, (gi + 1) * POOL_GROUP_DIM)
        csg = cs[..., sl]
        lag = jnp.pad(csg, ((0, 0), (win, 0), (0, 0)))[:, :S]
        mean = (csg - lag) / jnp.minimum(count, float(win))
        outs.append(mean - hf[..., sl])
    pooled = jnp.stack(outs, axis=2)
    y = jnp.einsum('bsgc,gcd->bsgd', pooled, pool_w.astype(jnp.float32)).reshape(Bn, S, POOL_DIM)
    return (y * pool_scale.astype(jnp.float32)).astype(h.dtype)


def short_gated_conv(gate_b, gate_c, hc, conv_w):
    return gate_b * causal_dwconv(gate_c * hc, conv_w)


def setup_inputs(seed: int = 0) -> dict:
    key = jax.random.key(seed)
    ks = jax.random.split(key, 24)
    f32 = jnp.float32
    nrm = lambda k, shape, scale: jax.random.normal(k, shape, f32) * scale
    dt = jnp.exp(jax.random.uniform(ks[5], (DEPTH, A_HEADS), f32, np.log(1e-3), np.log(1e-1)))
    return {
        'x': nrm(ks[0], (BATCH, SEQ, D_MODEL), 1.0),
        'p': nrm(ks[1], (DEPTH, BATCH, SEQ, PLE_DIM), 1.0),
        'norm1_g': 1.0 + nrm(ks[2], (DEPTH, D_MODEL), 0.02),
        'w_in': nrm(ks[3], (DEPTH, D_MODEL, D_IN), D_MODEL ** -0.5),
        'conv_qkv': nrm(ks[4], (DEPTH, QKV_CONV_WIDTH, 3 * A_DIM), QKV_CONV_WIDTH ** -0.5),
        'a_log': jnp.log(jax.random.uniform(ks[6], (DEPTH, A_HEADS), f32, 1.0, 16.0)),
        'dt_bias': jnp.log(jnp.expm1(dt)),
        'onorm_g': 1.0 + nrm(ks[7], (DEPTH, A_HEAD_DIM), 0.02),
        'pool_w': nrm(ks[8], (DEPTH, POOL_GROUPS, POOL_GROUP_DIM, POOL_GROUP_DIM), POOL_GROUP_DIM ** -0.5),
        'pool_scale': 1.0 + nrm(ks[9], (DEPTH, POOL_DIM), 0.02),
        'sconv_w': nrm(ks[10], (DEPTH, CONV_WIDTH, CONV_DIM), CONV_WIDTH ** -0.5),
        'w_out': nrm(ks[11], (DEPTH, D_MIX, D_MODEL), D_MIX ** -0.5),
        'norm2_g': 1.0 + nrm(ks[12], (DEPTH, D_MODEL), 0.02),
        'w_gate': nrm(ks[13], (DEPTH, D_MODEL, D_FF), D_MODEL ** -0.5),
        'w_up': nrm(ks[14], (DEPTH, D_MODEL, D_FF), D_MODEL ** -0.5),
        'w_down': nrm(ks[15], (DEPTH, D_FF, D_MODEL), D_FF ** -0.5),
        'ple_proj': nrm(ks[16], (DEPTH, PLE_DIM, D_MODEL), PLE_DIM ** -0.5),
        'ple_gate': nrm(ks[17], (DEPTH, D_MODEL, D_MODEL), D_MODEL ** -0.5),
        'final_g': 1.0 + nrm(ks[18], (D_MODEL,), 0.02),
    }


def reference(x, p, norm1_g, w_in, conv_qkv, a_log, dt_bias, onorm_g, pool_w, pool_scale,
              sconv_w, w_out, norm2_g, w_gate, w_up, w_down, ple_proj, ple_gate, final_g):
    offsets = [0]
    for s in IN_SIZES[:-1]:
        offsets.append(offsets[-1] + s)
    for i in range(DEPTH):
        h = rms_norm(x, norm1_g[i])
        proj = jnp.einsum('bsd,de->bse', h, w_in[i])
        q, k, v, z, a, b, hp, cb, cc, ch = jnp.split(proj, offsets[1:], axis=-1)
        o_a = gated_deltanet(q, k, v, z, a, b, conv_qkv[i], a_log[i], dt_bias[i], onorm_g[i])
        o_b = multiscale_pool(hp, pool_w[i], pool_scale[i])
        o_c = short_gated_conv(cb, cc, ch, sconv_w[i])
        mixed = jnp.concatenate([o_a, o_b, o_c], axis=-1)
        x = x + jnp.einsum('bse,ed->bsd', mixed, w_out[i])
        h = rms_norm(x, norm2_g[i])
        ff = jax.nn.silu(jnp.einsum('bsd,df->bsf', h, w_gate[i])) * jnp.einsum('bsd,df->bsf', h, w_up[i])
        x = x + jnp.einsum('bsf,fd->bsd', ff, w_down[i])
        gate = jax.nn.sigmoid(jnp.einsum('bsd,de->bse', x, ple_gate[i]).astype(jnp.float32)).astype(x.dtype)
        x = x + gate * jnp.einsum('bsq,qd->bsd', p[i], ple_proj[i])
    return rms_norm(x, final_g)
```

```cpp
#include <hip/hip_runtime.h>
#include <hip/hip_cooperative_groups.h>
#include <cstdio>
#include <cstdint>
namespace cg = cooperative_groups;
namespace pg8 {
#define PG8_LAS __attribute__((address_space(3)))
typedef unsigned short bf16_t;
typedef short bf16x8 __attribute__((ext_vector_type(8)));
typedef float f32x4 __attribute__((ext_vector_type(4)));
typedef unsigned u32x4 __attribute__((ext_vector_type(4)));
constexpr int BM = 256, BK = 64, HALF = 128, HTB = HALF * BK * 2  , STAGE_BYTES = 8 * HTB, NXCD = 8, WGM = 8;

__host__ __device__ __forceinline__ int lds_byte(int r, int c) { const int st = (r >> 4) * 2 + (c >> 5), rr = r & 15, cc = c & 31, ob = rr * 64 + cc * 2; return st * 1024 + (ob ^ (((ob >> 9) & 1) << 5)); }
__host__ __device__ __forceinline__ void stage_rc(int b, int& R, int& C) { const int st = b / 1024, sb = b % 1024, swz = sb ^ (((sb >> 9) & 1) << 5); R = (st >> 1) * 16 + swz / 64; C = (st & 1) * 32 + (swz % 64) / 2; }
__host__ __device__ __forceinline__ int perm32(int rho) { const int n = rho >> 4, i = rho & 15; return 8 * (i >> 2) + 4 * n + (i & 3); }

struct Unit { int pm, pn; };
struct Gemm { const bf16_t* A; const bf16_t* Bt; int M, N, K; };

struct StaticOrder {
    int nM, nN, nwg, G, c;
    __host__ __device__ void init(int M, int N, int G_, int c_) { nM = M / BM; nN = N / BM; nwg = nM * nN; G = G_; c = c_; }
    __host__ __device__ bool next(int i, Unit& u) const {
        const long L = (long)i * G + c; if (L >= nwg) return false;
        int wgid = (int)L; { const int q = nwg / NXCD, r = nwg % NXCD, xcd = wgid % NXCD, off = wgid / NXCD; wgid = (xcd < r ? xcd * (q + 1) : r * (q + 1) + (xcd - r) * q) + off; }
        const int nig = WGM * nN, gid = wgid / nig, fm = gid * WGM, gsz = (nM - fm) < WGM ? (nM - fm) : WGM;
        u.pm = fm + ((wgid % nig) % gsz); u.pn = (wgid % nig) / gsz; return true;
    }
    __device__ __forceinline__ void a_ready(const Unit&) const {}
    __device__ __forceinline__ void done(const Unit&) const {}
};

__device__ __forceinline__ unsigned cvt_pk_bf16(float lo, float hi) { unsigned r; asm volatile("v_cvt_pk_bf16_f32 %0, %1, %2" : "=v"(r) : "v"(lo), "v"(hi)); return r; }
template <class Epi, class Sched, bool ALIGN_EPI = false, bool SP2 = false>
__device__ __forceinline__ void gemm_phase(PG8_LAS unsigned char* lds, const Gemm g, const Sched& S, const Epi& E) {
    int tid_ = threadIdx.x; asm volatile("" : "+v"(tid_));
    const int tid = tid_, wid = __builtin_amdgcn_readfirstlane(tid >> 6), lane = tid & 63, wr = wid >> 2, wc = wid & 3, fr = lane & 15, fq = lane >> 4;
    const int K = g.K, nt = K / BK;
    unsigned voffA[2], voffB[2];
#pragma unroll
    for (int i = 0; i < 2; ++i) { int R, C; stage_rc(tid * 16 + i * 8192, R, C); const int Rb = Epi::PERM ? ((R & ~31) + perm32(R & 31)) : R;
        voffA[i] = (unsigned)(R * K + C) * 2u; voffB[i] = (unsigned)(Rb * K + C) * 2u; }
    const size_t kstep = (size_t)(BK * 2);
    const size_t hstep = (size_t)HALF * K * 2;
    const size_t tstep = 2 * hstep;
    const unsigned ldsw = (unsigned)wid * 1024u;
    const int aoff = lds_byte(wr * 64 + fr, fq * 8), boff = lds_byte(wc * 32 + fr, fq * 8);
#define PG8_SA(b, h) (((b) * 2 + (h)) * HTB)
#define PG8_SB(b, h) ((4 + (b) * 2 + (h)) * HTB)
#define PG8_STAGE(bufoff, gbase, voff) do { _Pragma("unroll") for (int _i = 0; _i < 2; ++_i) \
        __builtin_amdgcn_global_load_lds((const unsigned*)((const char*)(gbase) + (voff)[_i]), (PG8_LAS unsigned*)(lds + (bufoff) + ldsw + _i * 8192), 16, 0, 0); } while (0)
#define PG8_LDA(dst, b, h) do { _Pragma("unroll") for (int m = 0; m < 4; ++m) _Pragma("unroll") for (int k = 0; k < 2; ++k) dst[m][k] = *(const PG8_LAS bf16x8*)(lds + PG8_SA(b, h) + aoff + m * 2048 + k * 1024); } while (0)
#define PG8_LDB(dst, b, h) do { _Pragma("unroll") for (int n = 0; n < 2; ++n) _Pragma("unroll") for (int k = 0; k < 2; ++k) dst[n][k] = *(const PG8_LAS bf16x8*)(lds + PG8_SB(b, h) + boff + n * 2048 + k * 1024); } while (0)
#define PG8_MMA(ai, bj, At, Bt) do { __builtin_amdgcn_s_setprio(1); _Pragma("unroll") for (int m = 0; m < 4; ++m) _Pragma("unroll") for (int n = 0; n < 2; ++n) _Pragma("unroll") for (int k = 0; k < 2; ++k) \
        acc[ai][bj][m][n] = __builtin_amdgcn_mfma_f32_16x16x32_bf16(Bt[n][k], At[m][k], acc[ai][bj][m][n], 0, 0, 0); __builtin_amdgcn_s_setprio(0); } while (0)
#define PG8_WAIT_V(n) asm volatile("s_waitcnt vmcnt(" #n ")" ::: "memory")
#define PG8_WAIT_L(n) asm volatile("s_waitcnt lgkmcnt(" #n ")" ::: "memory")
#define PG8_BAR __builtin_amdgcn_s_barrier()
#define PG8_SCHED __builtin_amdgcn_sched_barrier(0)
    Unit cur, nxt; int ui = 0;
    if (!S.next(0, cur)) return;
    f32x4 acc[2][2][4][2];
#pragma unroll
    for (int a = 0; a < 2; ++a)
#pragma unroll
        for (int b = 0; b < 2; ++b)
#pragma unroll
            for (int m = 0; m < 4; ++m)
#pragma unroll
                for (int n = 0; n < 2; ++n) acc[a][b][m][n] = (f32x4){0.f, 0.f, 0.f, 0.f};
    bf16x8 At[4][2], B0[2][2], B1[2][2];
    const char* cA = (const char*)g.A + (size_t)cur.pm * tstep; const char* cB = (const char*)g.Bt + (size_t)cur.pn * tstep;
    S.a_ready(cur);
    if constexpr (SP2) {
        PG8_STAGE(PG8_SB(0, 0), cB, voffB); PG8_STAGE(PG8_SB(0, 1), cB + hstep, voffB); PG8_STAGE(PG8_SA(0, 0), cA, voffA); PG8_STAGE(PG8_SA(0, 1), cA + hstep, voffA);
        if (wr == 1) PG8_BAR;
        PG8_WAIT_V(2); PG8_BAR;
        PG8_STAGE(PG8_SB(1, 0), cB + kstep, voffB); PG8_STAGE(PG8_SA(1, 0), cA + kstep, voffA); PG8_STAGE(PG8_SB(1, 1), cB + hstep + kstep, voffB);
        PG8_WAIT_V(6); PG8_BAR;
    } else {
        PG8_STAGE(PG8_SB(0, 0), cB, voffB); PG8_STAGE(PG8_SA(0, 0), cA, voffA); PG8_STAGE(PG8_SB(0, 1), cB + hstep, voffB); PG8_STAGE(PG8_SA(0, 1), cA + hstep, voffA);
        if (wr == 1) PG8_BAR;
        PG8_WAIT_V(4); PG8_BAR;
        PG8_STAGE(PG8_SB(1, 0), cB + kstep, voffB); PG8_STAGE(PG8_SA(1, 0), cA + kstep, voffA); PG8_STAGE(PG8_SB(1, 1), cB + hstep + kstep, voffB);
        PG8_WAIT_V(6); PG8_BAR;
    }
    for (;;) {
        const bool has_next = S.next(ui + 1, nxt);
        const char* nA = has_next ? (const char*)g.A + (size_t)nxt.pm * tstep : cA; const char* nB = has_next ? (const char*)g.Bt + (size_t)nxt.pn * tstep : cB;
        for (int t = 0; t < nt; t += 2) {
            const bool last = (t == nt - 2);
            const char* a1 = cA + (size_t)(t + 1) * kstep;
            const char* a2 = last ? nA : cA + (size_t)(t + 2) * kstep; const char* b2 = last ? nB : cB + (size_t)(t + 2) * kstep;
            const char* a3 = a2 + kstep; const char* b3 = b2 + kstep;
            if (last && has_next) S.a_ready(nxt);
            if constexpr (SP2) {
            PG8_LDB(B0, 0, 0); PG8_LDB(B1, 0, 1); PG8_SCHED; PG8_LDA(At, 0, 0); PG8_STAGE(PG8_SA(1, 1), a1 + hstep, voffA);
            PG8_WAIT_V(8); PG8_WAIT_L(0); PG8_BAR; PG8_MMA(0, 0, At, B0); PG8_MMA(0, 1, At, B1); PG8_BAR; PG8_SCHED;
            PG8_LDA(At, 0, 1); PG8_STAGE(PG8_SB(0, 0), b2, voffB); PG8_STAGE(PG8_SB(0, 1), b2 + hstep, voffB); PG8_STAGE(PG8_SA(0, 0), a2, voffA);
            PG8_WAIT_V(8); PG8_WAIT_L(0); PG8_BAR; PG8_MMA(1, 0, At, B0); PG8_MMA(1, 1, At, B1); PG8_BAR; PG8_SCHED;
            PG8_LDB(B0, 1, 0); PG8_LDB(B1, 1, 1); PG8_SCHED; PG8_LDA(At, 1, 0); PG8_STAGE(PG8_SA(0, 1), a2 + hstep, voffA);
            PG8_WAIT_V(8); PG8_WAIT_L(0); PG8_BAR; PG8_MMA(0, 0, At, B0); PG8_MMA(0, 1, At, B1); PG8_BAR; PG8_SCHED;
            PG8_LDA(At, 1, 1); PG8_STAGE(PG8_SB(1, 0), b3, voffB); PG8_STAGE(PG8_SB(1, 1), b3 + hstep, voffB); PG8_STAGE(PG8_SA(1, 0), a3, voffA);
            PG8_WAIT_V(8); PG8_WAIT_L(0); PG8_BAR; PG8_MMA(1, 0, At, B0); PG8_MMA(1, 1, At, B1); PG8_BAR; PG8_SCHED;
            } else {
            PG8_LDB(B0, 0, 0); PG8_SCHED; PG8_LDA(At, 0, 0); PG8_STAGE(PG8_SA(1, 1), a1 + hstep, voffA);
            PG8_WAIT_L(8); PG8_BAR; PG8_WAIT_L(0); PG8_MMA(0, 0, At, B0); PG8_BAR; PG8_SCHED;
            PG8_LDB(B1, 0, 1); PG8_STAGE(PG8_SB(0, 0), b2, voffB);
            PG8_BAR; PG8_WAIT_L(0); PG8_MMA(0, 1, At, B1); PG8_BAR;
            PG8_LDA(At, 0, 1); PG8_STAGE(PG8_SA(0, 0), a2, voffA);
            PG8_BAR; PG8_WAIT_L(0); PG8_MMA(1, 0, At, B0); PG8_BAR; PG8_SCHED;
            PG8_STAGE(PG8_SB(0, 1), b2 + hstep, voffB);
            PG8_WAIT_V(6); PG8_BAR; PG8_MMA(1, 1, At, B1); PG8_BAR;
            PG8_LDB(B0, 1, 0); PG8_SCHED; PG8_LDA(At, 1, 0); PG8_STAGE(PG8_SA(0, 1), a2 + hstep, voffA);
            PG8_WAIT_L(8); PG8_BAR; PG8_WAIT_L(0); PG8_MMA(0, 0, At, B0); PG8_BAR; PG8_SCHED;
            PG8_LDB(B1, 1, 1); PG8_STAGE(PG8_SB(1, 0), b3, voffB);
            PG8_BAR; PG8_WAIT_L(0); PG8_MMA(0, 1, At, B1); PG8_BAR;
            PG8_LDA(At, 1, 1); PG8_STAGE(PG8_SA(1, 0), a3, voffA);
            PG8_BAR; PG8_WAIT_L(0); PG8_MMA(1, 0, At, B0); PG8_BAR; PG8_SCHED;
            PG8_STAGE(PG8_SB(1, 1), b3 + hstep, voffB);
            PG8_WAIT_V(6); PG8_BAR; PG8_MMA(1, 1, At, B1); PG8_BAR;
            }
        }
        if constexpr (ALIGN_EPI) { if (wr == 0) PG8_BAR; }
        if constexpr (!Epi::AFTER_DRAIN) { E(acc, cur, wr, wc, fr, fq); S.done(cur); }
        if (!has_next) break;
#pragma unroll
        for (int a = 0; a < 2; ++a)
#pragma unroll
            for (int b = 0; b < 2; ++b)
#pragma unroll
                for (int m = 0; m < 4; ++m)
#pragma unroll
                    for (int n = 0; n < 2; ++n) acc[a][b][m][n] = (f32x4){0.f, 0.f, 0.f, 0.f};
        cur = nxt; cA = nA; cB = nB; ++ui;
        if constexpr (ALIGN_EPI) { if (wr == 1) PG8_BAR; }
    }
    PG8_WAIT_V(0);
    if constexpr (!ALIGN_EPI) { if (wr == 0) PG8_BAR; }
    PG8_BAR;
    if constexpr (Epi::AFTER_DRAIN) { E.fused(acc, cur, wr, wc, fr, fq, lds, wid, lane); S.done(cur); }
#undef PG8_SA
#undef PG8_SB
#undef PG8_STAGE
#undef PG8_LDA
#undef PG8_LDB
#undef PG8_MMA
#undef PG8_WAIT_V
#undef PG8_WAIT_L
#undef PG8_BAR
#undef PG8_SCHED
}
}
#ifndef ALIGN1
#define ALIGN1 true
#endif
#ifndef REP_SC
#define REP_SC 1
#endif
#ifndef REP_SE
#define REP_SE 1
#endif
#ifndef REP_SCAN
#define REP_SCAN 1
#endif
#ifndef REP_MIX
#define REP_MIX 1
#endif
#ifndef REP_SA
#define REP_SA 1
#endif
#ifndef REP_SD
#define REP_SD 1
#endif
#ifndef REP_AB
#define REP_AB 1
#endif
#ifndef REP_P1
#define REP_P1 1
#endif
#ifndef REP_P2
#define REP_P2 1
#endif
#ifndef REP_P3
#define REP_P3 1
#endif
#ifndef REP_P4
#define REP_P4 1
#endif
#ifndef REP_P5
#define REP_P5 1
#endif
#ifndef REP_P7
#define REP_P7 1
#endif
#ifndef REP_P8
#define REP_P8 1
#endif
#ifndef REP_SYNC
#define REP_SYNC 1
#endif

namespace pg8 {
__device__ __forceinline__ float silu_f(float x) { return x * __builtin_amdgcn_rcpf(1.f + __builtin_amdgcn_exp2f(-1.4426950408889634f * x)); }
__device__ __forceinline__ float sigmoid_f(float x) { return __builtin_amdgcn_rcpf(1.f + __builtin_amdgcn_exp2f(-1.4426950408889634f * x)); }
__device__ __forceinline__ u32x4 pack8(const f32x4 a, const f32x4 b) { u32x4 w; w.x = cvt_pk_bf16(a[0], a[1]); w.y = cvt_pk_bf16(a[2], a[3]); w.z = cvt_pk_bf16(b[0], b[1]); w.w = cvt_pk_bf16(b[2], b[3]); return w; }

struct EpiBf16S {
    static constexpr bool PERM = true, AFTER_DRAIN = false;
    bf16_t* O; bf16_t* O2; int ldc; int split;
    __device__ __forceinline__ void operator()(const f32x4 (&acc)[2][2][4][2], const Unit& u, int wr, int wc, int fr, int fq) const {
        const int row0 = u.pm * BM + wr * 64 + fr; int colt = u.pn * BM; bf16_t* base = O;
        if (colt >= split) { base = O2; colt -= split; }
        const int col0 = colt + wc * 32 + 8 * fq;
#pragma unroll
        for (int ai = 0; ai < 2; ++ai)
#pragma unroll
            for (int m = 0; m < 4; ++m) { bf16_t* rowp = base + (size_t)(row0 + ai * HALF + m * 16) * ldc + col0;
#pragma unroll
                for (int bj = 0; bj < 2; ++bj) *(u32x4*)(rowp + bj * HALF) = pack8(acc[ai][bj][m][0], acc[ai][bj][m][1]); }
    }
};
struct EpiSwiglu {
    static constexpr bool PERM = true, AFTER_DRAIN = false;
    bf16_t* O; int ldc;
    __device__ __forceinline__ void operator()(const f32x4 (&acc)[2][2][4][2], const Unit& u, int wr, int wc, int fr, int fq) const {
        const int row0 = u.pm * BM + wr * 64 + fr; const int col0 = u.pn * HALF + wc * 32 + 8 * fq;
#pragma unroll
        for (int ai = 0; ai < 2; ++ai)
#pragma unroll
            for (int m = 0; m < 4; ++m) {
                f32x4 v0, v1;
#pragma unroll
                for (int j = 0; j < 4; ++j) { v0[j] = silu_f(acc[ai][0][m][0][j]) * acc[ai][1][m][0][j]; v1[j] = silu_f(acc[ai][0][m][1][j]) * acc[ai][1][m][1][j]; }
                *(u32x4*)(O + (size_t)(row0 + ai * HALF + m * 16) * ldc + col0) = pack8(v0, v1); }
    }
};
struct EpiRes {
    static constexpr bool PERM = true, AFTER_DRAIN = false;
    const float* base; float* out; bf16_t* outb;
    __device__ __forceinline__ void operator()(const f32x4 (&acc)[2][2][4][2], const Unit& u, int wr, int wc, int fr, int fq) const {
        const int row0 = u.pm * BM + wr * 64 + fr; const int col0 = u.pn * BM + wc * 32 + 8 * fq;
#pragma unroll
        for (int ai = 0; ai < 2; ++ai) {
            f32x4 rb[4][2][2];
#pragma unroll
            for (int m = 0; m < 4; ++m) { const size_t off = (size_t)(row0 + ai * HALF + m * 16) * 1024 + col0;
#pragma unroll
                for (int bj = 0; bj < 2; ++bj) { rb[m][bj][0] = __builtin_nontemporal_load((const f32x4*)(base + off + bj * HALF)); rb[m][bj][1] = __builtin_nontemporal_load((const f32x4*)(base + off + bj * HALF + 4)); } }
            __builtin_amdgcn_sched_barrier(0);
#pragma unroll
            for (int m = 0; m < 4; ++m) { const size_t off = (size_t)(row0 + ai * HALF + m * 16) * 1024 + col0;
#pragma unroll
                for (int bj = 0; bj < 2; ++bj) {
                    const f32x4 v0 = rb[m][bj][0] + acc[ai][bj][m][0], v1 = rb[m][bj][1] + acc[ai][bj][m][1];
                    if (out) { __builtin_nontemporal_store(v0, (f32x4*)(out + off + bj * HALF)); __builtin_nontemporal_store(v1, (f32x4*)(out + off + bj * HALF + 4)); }
                    if (outb) *(u32x4*)(outb + off + bj * HALF) = pack8(v0, v1); } }
            __builtin_amdgcn_sched_barrier(0);
        }
    }
};
struct EpiPle {
    static constexpr bool PERM = true, AFTER_DRAIN = false;
    float* x; const bf16_t* pp;
    __device__ __forceinline__ void operator()(const f32x4 (&acc)[2][2][4][2], const Unit& u, int wr, int wc, int fr, int fq) const {
        const int row0 = u.pm * BM + wr * 64 + fr; const int col0 = u.pn * BM + wc * 32 + 8 * fq;
#pragma unroll
        for (int ai = 0; ai < 2; ++ai)
#pragma unroll
            for (int mp = 0; mp < 2; ++mp) {
                f32x4 rb[2][2][2]; u32x4 rp[2][2];
#pragma unroll
                for (int mm = 0; mm < 2; ++mm) { const size_t off = (size_t)(row0 + ai * HALF + (2 * mp + mm) * 16) * 1024 + col0;
#pragma unroll
                    for (int bj = 0; bj < 2; ++bj) { rb[mm][bj][0] = *(const f32x4*)(x + off + bj * HALF); rb[mm][bj][1] = *(const f32x4*)(x + off + bj * HALF + 4); rp[mm][bj] = *(const u32x4*)(pp + off + bj * HALF); } }
                __builtin_amdgcn_sched_barrier(0);
#pragma unroll
                for (int mm = 0; mm < 2; ++mm) { const int m = 2 * mp + mm; const size_t off = (size_t)(row0 + ai * HALF + m * 16) * 1024 + col0;
#pragma unroll
                    for (int bj = 0; bj < 2; ++bj) {
                        const f32x4 b0 = rb[mm][bj][0], b1 = rb[mm][bj][1]; const u32x4 pw = rp[mm][bj];
                        f32x4 p0, p1;
                        p0[0] = __uint_as_float(pw.x << 16); p0[1] = __uint_as_float(pw.x & 0xffff0000u); p0[2] = __uint_as_float(pw.y << 16); p0[3] = __uint_as_float(pw.y & 0xffff0000u);
                        p1[0] = __uint_as_float(pw.z << 16); p1[1] = __uint_as_float(pw.z & 0xffff0000u); p1[2] = __uint_as_float(pw.w << 16); p1[3] = __uint_as_float(pw.w & 0xffff0000u);
                        f32x4 v0, v1;
#pragma unroll
                        for (int j = 0; j < 4; ++j) { v0[j] = b0[j] + sigmoid_f(acc[ai][bj][m][0][j]) * p0[j]; v1[j] = b1[j] + sigmoid_f(acc[ai][bj][m][1][j]) * p1[j]; }
                        *(f32x4*)(x + off + bj * HALF) = v0; *(f32x4*)(x + off + bj * HALF + 4) = v1; } }
                __builtin_amdgcn_sched_barrier(0);
            }
    }
};

template <int MODE> struct EpiNorm {
    static constexpr bool PERM = true, AFTER_DRAIN = true;
    const float* base; float* out; const bf16_t* pp; bf16_t* nb; const float* g; unsigned* xbuf; unsigned* cnt; const bf16_t* b16;
    __device__ __forceinline__ void operator()(const f32x4 (&)[2][2][4][2], const Unit&, int, int, int, int) const {}
    __device__ __forceinline__ void fused(f32x4 (&acc)[2][2][4][2], const Unit& u, int wr, int wc, int fr, int fq, PG8_LAS unsigned char* lds, int wid, int lane) const {
        PG8_LAS float* Pp = (PG8_LAS float*)lds;
        PG8_LAS float* Ss = (PG8_LAS float*)(lds + 8192);
        const int row0 = u.pm * BM + wr * 64 + fr; const int col0 = u.pn * BM + wc * 32 + 8 * fq;
#pragma unroll
        for (int ai = 0; ai < 2; ++ai)
#pragma unroll
            for (int m = 0; m < 4; ++m) { const size_t off = (size_t)(row0 + ai * HALF + m * 16) * 1024 + col0; float sq = 0.f;
#pragma unroll
                for (int bj = 0; bj < 2; ++bj) {
                    f32x4 b0, b1;
                    if (MODE == 0) { b0 = __builtin_nontemporal_load((const f32x4*)(base + off + bj * HALF)); b1 = __builtin_nontemporal_load((const f32x4*)(base + off + bj * HALF + 4)); }
                    else { const u32x4 xw = *(const u32x4*)(b16 + off + bj * HALF);
                        b0[0] = __uint_as_float(xw.x << 16); b0[1] = __uint_as_float(xw.x & 0xffff0000u); b0[2] = __uint_as_float(xw.y << 16); b0[3] = __uint_as_float(xw.y & 0xffff0000u);
                        b1[0] = __uint_as_float(xw.z << 16); b1[1] = __uint_as_float(xw.z & 0xffff0000u); b1[2] = __uint_as_float(xw.w << 16); b1[3] = __uint_as_float(xw.w & 0xffff0000u); }
                    f32x4 v0, v1;
                    if (MODE == 0) { v0 = b0 + acc[ai][bj][m][0]; v1 = b1 + acc[ai][bj][m][1]; }
                    else { const u32x4 pw = *(const u32x4*)(pp + off + bj * HALF); f32x4 p0, p1;
                        p0[0] = __uint_as_float(pw.x << 16); p0[1] = __uint_as_float(pw.x & 0xffff0000u); p0[2] = __uint_as_float(pw.y << 16); p0[3] = __uint_as_float(pw.y & 0xffff0000u);
                        p1[0] = __uint_as_float(pw.z << 16); p1[1] = __uint_as_float(pw.z & 0xffff0000u); p1[2] = __uint_as_float(pw.w << 16); p1[3] = __uint_as_float(pw.w & 0xffff0000u);
#pragma unroll
                        for (int j = 0; j < 4; ++j) { v0[j] = b0[j] + sigmoid_f(acc[ai][bj][m][0][j]) * p0[j]; v1[j] = b1[j] + sigmoid_f(acc[ai][bj][m][1][j]) * p1[j]; } }
                    if (MODE != 2) { __builtin_nontemporal_store(v0, (f32x4*)(out + off + bj * HALF)); __builtin_nontemporal_store(v1, (f32x4*)(out + off + bj * HALF + 4)); }
                    acc[ai][bj][m][0] = v0; acc[ai][bj][m][1] = v1;
                    sq += (v0[0] * v0[0] + v0[1] * v0[1]) + (v0[2] * v0[2] + v0[3] * v0[3]) + (v1[0] * v1[0] + v1[1] * v1[1]) + (v1[2] * v1[2] + v1[3] * v1[3]); }
                sq += __shfl_xor(sq, 16); sq += __shfl_xor(sq, 32);
                if (fq == 0) Pp[(ai * HALF + wr * 64 + m * 16 + fr) * 4 + wc] = sq; }
        asm volatile("s_waitcnt lgkmcnt(0)" ::: "memory"); __builtin_amdgcn_s_barrier(); asm volatile("" ::: "memory");
        const int row = wid * 32 + (lane & 31);
        if (lane < 32) { const float s = (Pp[row * 4 + 0] + Pp[row * 4 + 1]) + (Pp[row * 4 + 2] + Pp[row * 4 + 3]);
            __hip_atomic_store(xbuf + ((size_t)(u.pm * BM + row) * 4 + u.pn), __float_as_uint(s), __ATOMIC_RELAXED, __HIP_MEMORY_SCOPE_AGENT); }
        asm volatile("s_waitcnt vmcnt(0)" ::: "memory");
        if (lane == 0) __hip_atomic_fetch_add(cnt + 64 * u.pm, 1u, __ATOMIC_RELAXED, __HIP_MEMORY_SCOPE_AGENT);
        if (wid == 0) { unsigned spins = 0;
            while ((unsigned)__builtin_amdgcn_readfirstlane(__hip_atomic_load(cnt + 64 * u.pm, __ATOMIC_RELAXED, __HIP_MEMORY_SCOPE_AGENT)) < 32u && ++spins < (1u << 22)) __builtin_amdgcn_s_sleep(2);
            __builtin_amdgcn_fence(__ATOMIC_ACQUIRE, "agent"); }
        asm volatile("s_waitcnt vmcnt(0) lgkmcnt(0)" ::: "memory"); __builtin_amdgcn_s_barrier(); asm volatile("" ::: "memory");
        if (lane < 32) { const unsigned* sl = xbuf + (size_t)(u.pm * BM + row) * 4; float t = 0.f;
#pragma unroll
            for (int k = 0; k < 4; ++k) t += __uint_as_float(__hip_atomic_load(sl + k, __ATOMIC_RELAXED, __HIP_MEMORY_SCOPE_AGENT));
            Ss[row] = rsqrtf(t * (1.f / 1024.f) + 1e-6f); }
        asm volatile("s_waitcnt vmcnt(0) lgkmcnt(0)" ::: "memory"); __builtin_amdgcn_s_barrier(); asm volatile("" ::: "memory");
        f32x4 gv[2][2];
#pragma unroll
        for (int bj = 0; bj < 2; ++bj) { gv[bj][0] = *(const f32x4*)(g + col0 + bj * HALF); gv[bj][1] = *(const f32x4*)(g + col0 + bj * HALF + 4); }
#pragma unroll
        for (int ai = 0; ai < 2; ++ai)
#pragma unroll
            for (int m = 0; m < 4; ++m) { const int rl = ai * HALF + wr * 64 + m * 16 + fr; const float rs = Ss[rl]; const size_t off = (size_t)(u.pm * BM + rl) * 1024 + col0;
#pragma unroll
                for (int bj = 0; bj < 2; ++bj) { const f32x4 o0 = acc[ai][bj][m][0] * rs * gv[bj][0], o1 = acc[ai][bj][m][1] * rs * gv[bj][1];
                    if (MODE == 2) { __builtin_nontemporal_store(o0, (f32x4*)(out + off + bj * HALF)); __builtin_nontemporal_store(o1, (f32x4*)(out + off + bj * HALF + 4)); }
                    else *(u32x4*)(nb + off + bj * HALF) = pack8(o0, o1); } }
    }
};
}

#define LAS __attribute__((address_space(3)))
typedef unsigned short bf16;
typedef float f32x4 __attribute__((ext_vector_type(4)));
typedef float f32x16 __attribute__((ext_vector_type(16)));
typedef short bf16x8 __attribute__((ext_vector_type(8)));
typedef unsigned u32x4 __attribute__((ext_vector_type(4)));
typedef unsigned u32x2 __attribute__((ext_vector_type(2)));
constexpr int NB = 8, SEQ = 2048, DM = 1024, M = NB * SEQ, DEPTH = 2, PLE = 256, DFF = 2816, DIN = 3080, NPROJ = 3072, PHALF = 1536;
constexpr float EPS = 1e-6f;
constexpr int NTHREADS = 512, NWAVES = 8;
constexpr int LDS_BYTES = 145408;
constexpr size_t MiB = 1u << 20;
constexpr size_t WS_SMALL = 1 * MiB;
constexpr size_t WS_W = 2 * MiB;
constexpr size_t WO_IN = 0, WO_AB = 6 * MiB, WO_OUT = WO_AB + 65536, WO_GU = WO_OUT + 2 * MiB, WO_DOWN = WO_GU + 11 * MiB, WO_PG = WO_DOWN + 5632 * 1024, WO_PP = WO_PG + 2 * MiB, WO_END = WO_PP + 512 * 1024;
static_assert(WO_END <= 28 * MiB, "weights region");
constexpr size_t WS_HB = 30 * MiB;
constexpr size_t WS_PA = 62 * MiB;
constexpr size_t WS_PB = 110 * MiB;
constexpr size_t WS_REC = 158 * MiB;
constexpr size_t WS_U = 219 * MiB;
constexpr size_t WS_END = 254 * MiB;
constexpr int REC_BYTES = 62464, RO_NEGW = 0, RO_QE = 17408, RO_KDT = 34816, RO_ATTN = 53248;

__device__ __forceinline__ unsigned f2bf(float f) { unsigned u = __builtin_bit_cast(unsigned, f); return (u + 0x7fffu + ((u >> 16) & 1u)) >> 16; }
__device__ __forceinline__ unsigned pk2(float lo, float hi) { return pg8::cvt_pk_bf16(lo, hi); }
__device__ __forceinline__ float bf_lo(unsigned w) { return __uint_as_float(w << 16); }
__device__ __forceinline__ float bf_hi(unsigned w) { return __uint_as_float(w & 0xffff0000u); }
__device__ __forceinline__ float wave_sum(float v) {
#pragma unroll
    for (int o = 1; o < 64; o <<= 1) v += __shfl_xor(v, o);
    return v;
}
__device__ __forceinline__ int crow(int reg, int h) { return (reg & 3) + 8 * (reg >> 2) + 4 * h; }
__device__ __forceinline__ int swap23(int x) { return (x & ~12) | ((x & 4) << 1) | ((x & 8) >> 1); }
#define MFMA32(a, b, c) __builtin_amdgcn_mfma_f32_32x32x16_bf16((a), (b), (c), 0, 0, 0)
typedef float f32x2_t __attribute__((ext_vector_type(2))); typedef __bf16 bf16x2_t __attribute__((ext_vector_type(2)));
__device__ __forceinline__ unsigned cvtpk_c(float lo, float hi) { f32x2_t v = {lo, hi}; bf16x2_t b = __builtin_convertvector(v, bf16x2_t); return __builtin_bit_cast(unsigned, b); }
__device__ __forceinline__ bf16x8 pack_step(const f32x16& x, int s) {
    u32x4 p; p.x = cvtpk_c(x[8 * s], x[8 * s + 1]); p.y = cvtpk_c(x[8 * s + 2], x[8 * s + 3]); p.z = cvtpk_c(x[8 * s + 4], x[8 * s + 5]); p.w = cvtpk_c(x[8 * s + 6], x[8 * s + 7]);
    return __builtin_bit_cast(bf16x8, p);
}

__device__ __forceinline__ void transpose_item(const float* W, int ldw, int k0, int srcc0, bf16* WT, int ldt, int dstr0, LAS float* scr, int lane) {
    float wv_[32];
#pragma unroll
    for (int i = 0; i < 32; ++i) { const int kk = 2 * i + (lane >> 5); wv_[i] = W[(size_t)(k0 + kk) * ldw + srcc0 + (lane & 31)]; }
#pragma unroll
    for (int i = 0; i < 32; ++i) { const int kk = 2 * i + (lane >> 5); scr[kk * 33 + (lane & 31)] = wv_[i]; }
    asm volatile("s_waitcnt lgkmcnt(0)" ::: "memory");
    const int c = lane & 7;
#pragma unroll
    for (int j = 0; j < 4; ++j) { const int n = (lane >> 3) + 8 * j; const LAS float* s = scr + (8 * c) * 33 + n;
        u32x4 o; o.x = pk2(s[0 * 33], s[1 * 33]); o.y = pk2(s[2 * 33], s[3 * 33]); o.z = pk2(s[4 * 33], s[5 * 33]); o.w = pk2(s[6 * 33], s[7 * 33]);
        *(u32x4*)(WT + (size_t)(dstr0 + n) * ldt + k0 + 8 * c) = o; }
    asm volatile("s_waitcnt lgkmcnt(0)" ::: "memory");
}

#define XB_TMO      128
#define XB_XCNT(j)  (256  + 64 * (j))
#define XB_XSUB(j)  (1280 + 64 * (j))
#define XB_XGEN(j)  (2304 + 64 * (j))
#define XB_TOP      3328
#define XB_TOPGEN   3392
#define XCD_BAR_WORDS 3456
#define XB_SPIN_CAP (1u << 18)

__device__ __forceinline__ unsigned xb_ld(unsigned* p)              { return __hip_atomic_load(p, __ATOMIC_RELAXED, __HIP_MEMORY_SCOPE_AGENT); }
__device__ __forceinline__ unsigned xb_add(unsigned* p, unsigned v) { return __hip_atomic_fetch_add(p, v, __ATOMIC_RELAXED, __HIP_MEMORY_SCOPE_AGENT); }
__device__ __forceinline__ unsigned xb_xcc_id() { return (unsigned)__builtin_amdgcn_s_getreg((3 << 11) | 20) & 0xFu; }
#define XB_SPIN(cond, bar) do { unsigned _sp = 0; while (cond) { __builtin_amdgcn_s_sleep(1); \
    if ((++_sp & 255u) == 0u) { if (xb_ld(&(bar)[XB_TMO])) break; if (_sp > XB_SPIN_CAP) { atomicAdd(&(bar)[XB_TMO], 1u); break; } } } } while (0)

struct XcdBarrier {
    unsigned* bar; unsigned x;
    volatile LAS unsigned* st;
};

__device__ __forceinline__ XcdBarrier xcd_barrier_post(unsigned* bar, volatile LAS unsigned* st) {
    XcdBarrier b; b.bar = bar; b.x = xb_xcc_id(); b.st = st;
    if (threadIdx.x == 0) (void)xb_add(&bar[XB_XCNT(b.x)], 1u);
    return b;
}
__device__ __forceinline__ void xcd_barrier_complete(unsigned* bar, unsigned x, unsigned& nloc, unsigned& nx) {
    const unsigned G = gridDim.x * gridDim.y * gridDim.z;
    unsigned sum, cnt, mine, sp = 0u;
    for (;;) {
        sum = 0u; cnt = 0u; mine = 0u;
#pragma unroll
        for (unsigned j = 0; j < 16; ++j) { const unsigned c = xb_ld(&bar[XB_XCNT(j)]); sum += c; cnt += (c > 0u) ? 1u : 0u; mine = (j == x) ? c : mine; }
        if (sum == G) break;
        __builtin_amdgcn_s_sleep(1);
        if ((++sp & 255u) == 0u) { if (xb_ld(&bar[XB_TMO])) break; if (sp > XB_SPIN_CAP) { atomicAdd(&bar[XB_TMO], 1u); break; } }
    }
    nloc = mine > 0u ? mine : 1u; nx = cnt > 0u ? cnt : 1u;
}

__device__ __forceinline__ void xcd_barrier(const XcdBarrier& b) {
    asm volatile("s_waitcnt vmcnt(0)" ::: "memory");
    __syncthreads();
    if (threadIdx.x == 0) {
        unsigned* bar = b.bar;
        __builtin_amdgcn_s_waitcnt(0);
        unsigned nloc = b.st[0], nx = b.st[1];
        if (nloc == 0u) { xcd_barrier_complete(bar, b.x, nloc, nx); b.st[0] = nloc; b.st[1] = nx; }
        const unsigned old = xb_add(&bar[XB_XSUB(b.x)], 1u);
        const unsigned gen = old / nloc;
        if (old + 1u == (gen + 1u) * nloc) {
            __builtin_amdgcn_fence(__ATOMIC_RELEASE, "agent");
            asm volatile("s_waitcnt vmcnt(0)" ::: "memory");
            const unsigned og = xb_add(&bar[XB_TOP], 1u);
            const unsigned tg = og / nx;
            if (og + 1u == (tg + 1u) * nx) xb_add(&bar[XB_TOPGEN], 1u);
            else XB_SPIN(xb_ld(&bar[XB_TOPGEN]) == tg, bar);
            __builtin_amdgcn_fence(__ATOMIC_ACQUIRE, "agent");
            xb_add(&bar[XB_XGEN(b.x)], 1u);
            asm volatile("s_waitcnt vmcnt(0)" ::: "memory");
        } else {
            XB_SPIN(xb_ld(&bar[XB_XGEN(b.x)]) == gen, bar);
            __builtin_amdgcn_fence(__ATOMIC_ACQUIRE, "agent");
            asm volatile("s_waitcnt vmcnt(0)" ::: "memory");
        }
    }
    __syncthreads();
}

#define WG_BAR() do { asm volatile("s_waitcnt lgkmcnt(0)" ::: "memory"); __builtin_amdgcn_s_barrier(); asm volatile("" ::: "memory"); } while (0)
struct Params { const float* in[19]; float* out; unsigned char* ws; };

__global__ void __launch_bounds__(NTHREADS, 2) fwd_kernel(Params P) {
    extern __shared__ __attribute__((aligned(16))) unsigned char lds_raw[];
    LAS unsigned char* lds = (LAS unsigned char*)lds_raw;
    cg::grid_group grid = cg::this_grid();
    volatile LAS unsigned* xb_st = (volatile LAS unsigned*)(lds + 145152);
    if (threadIdx.x < 2) xb_st[threadIdx.x] = 0u;
    __syncthreads();
    XcdBarrier xbar = xcd_barrier_post((unsigned*)P.ws, xb_st);
    if (P.ws == nullptr) grid.sync();
#define PH_BEGIN \
    int tid = threadIdx.x; asm volatile("" : "+v"(tid)); \
    const int lane = tid & 63, wave = __builtin_amdgcn_readfirstlane(tid >> 6); \
    int G = gridDim.x, bid = blockIdx.x; asm volatile("" : "+s"(G), "+s"(bid)); \
    const int gw = bid * NWAVES + wave, NGW = G * NWAVES, gt = bid * NTHREADS + tid, NGT = G * NTHREADS; \
    const int r32 = lane & 31, hh = lane >> 5; \
    int Lq = L; asm volatile("" : "+s"(Lq)); \
    __attribute__((address_space(1))) unsigned char* wsg_ = (__attribute__((address_space(1))) unsigned char*)P.ws; asm volatile("" : "+s"(wsg_)); \
    unsigned char* ws = (unsigned char*)wsg_;     \
    (void)gw; (void)NGW; (void)gt; (void)NGT; (void)r32; (void)hh; (void)lane; (void)wave; (void)G; (void)bid; (void)Lq; (void)ws;
#define XRES (P.out)
#define HB ((bf16*)(ws + WS_HB))
#define PA ((bf16*)(ws + WS_PA))
#define PB ((bf16*)(ws + WS_PB))
#define FF ((bf16*)(ws + WS_PA))
#define OB ((float*)(ws + WS_PA))
#define REC (ws + WS_REC)
#define PBF ((bf16*)(ws + WS_REC))
#define UB ((float*)(ws + WS_U))
#define PP ((bf16*)(ws + WS_U))
#define GL ((float*)(ws + WS_SMALL))
#define XB ((bf16*)(ws + WS_REC + 16 * MiB))
#define XCH(bank) ((unsigned*)(ws + 253 * MiB + (size_t)(bank) * 262144))
#define XCNT(bank) ((unsigned*)(ws + 65536 + (size_t)(bank) * 16384))
#define GARR ((float*)(ws + WS_SMALL + 262144))
#define BARR ((float*)(ws + WS_SMALL + 524288))
#define Win_t ((bf16*)(ws + WS_W + WO_IN))
#define Wab_t ((bf16*)(ws + WS_W + WO_AB))
#define Wout_t ((bf16*)(ws + WS_W + WO_OUT))
#define Wgu_t ((bf16*)(ws + WS_W + WO_GU))
#define Wdown_t ((bf16*)(ws + WS_W + WO_DOWN))
#define Wpg_t ((bf16*)(ws + WS_W + WO_PG))
#define Wpp_t ((bf16*)(ws + WS_W + WO_PP))

    for (int L = 0; L < DEPTH; ++L) {
#ifndef SKIP_P1
        if (L == 0)
        for (int rep_ = 0; rep_ < REP_P1; ++rep_)
        {
        {
            PH_BEGIN
            const float* xin = (Lq == 0) ? P.in[0] : XRES;
            const float* norm1_g = P.in[2] + Lq * DM; const float* w_in = P.in[3] + (size_t)Lq * DM * DIN;
            const float* w_out = P.in[11] + (size_t)Lq * DM * DM;
            const float* w_gate = P.in[13] + (size_t)Lq * DM * DFF; const float* w_up = P.in[14] + (size_t)Lq * DM * DFF; const float* w_down = P.in[15] + (size_t)Lq * DFF * DM;
            const float* ple_proj = P.in[16] + (size_t)Lq * PLE * DM; const float* ple_gate = P.in[17] + (size_t)Lq * DM * DM;
            LAS float* scr = (LAS float*)(lds + wave * 8448);
            for (int it = gw; it < 16 * 96; it += NGW) { const int kb = it / 96, nb = it % 96; const int d0 = 32 * nb; transpose_item(w_in, DIN, 64 * kb, d0 < 2048 ? d0 : d0 + 8, Win_t, DM, d0, scr, lane); }
            for (int i = gt; i < 8 * DM; i += NGT) { const int n = i >> 10, k = i & 1023; Wab_t[n * DM + k] = (bf16)f2bf(w_in[(size_t)k * DIN + 2048 + n]); }
            if (Lq == 0)
            for (int mi = (bid >> 3) * NWAVES + wave; mi < SEQ; mi += (G >> 3) * NWAVES) {
                const int m = (bid & 7) * SEQ + mi;
                const f32x4* xr = (const f32x4*)(xin + (size_t)m * DM) + lane; f32x4 v[4]; float s = 0.f;
#pragma unroll
                for (int j = 0; j < 4; ++j) { v[j] = xr[64 * j]; s += (v[j].x * v[j].x + v[j].y * v[j].y) + (v[j].z * v[j].z + v[j].w * v[j].w); }
                const float rstd = rsqrtf(wave_sum(s) * (1.f / DM) + EPS);
                u32x2* o8 = (u32x2*)(XB + (size_t)m * DM) + lane;
#pragma unroll
                for (int j = 0; j < 4; ++j) { const f32x4 gv = ((const f32x4*)norm1_g)[lane + 64 * j]; u32x2 w; w.x = pk2(v[j].x * rstd * gv.x, v[j].y * rstd * gv.y); w.y = pk2(v[j].z * rstd * gv.z, v[j].w * rstd * gv.w); o8[64 * j] = w; }
            }
        }
        }
#endif
        if (L == 0) { for (int rs_ = 0; rs_ < REP_SYNC; ++rs_) xcd_barrier(xbar); }

#ifndef SKIP_P2
        for (int rep_ = 0; rep_ < REP_P2; ++rep_)
        {
        {
            PH_BEGIN
            const float* a_log = P.in[5] + Lq * 4; const float* dt_bias = P.in[6] + Lq * 4;
            pg8::Gemm g{XB, Win_t, M, NPROJ, DM}; pg8::StaticOrder S; S.init(M, NPROJ, G, bid);
            pg8::EpiBf16S E{PA, PB, PHALF, PHALF};
            pg8::gemm_phase<pg8::EpiBf16S, pg8::StaticOrder, true, true>(lds, g, S, E);
            for (int ub = bid; ub < M / 64; ub += G) { const int unit = (ub & 7) * 32 + (ub >> 3);
                const size_t row0 = (size_t)unit * 64; const int tile = wave & 3, kh = wave >> 2;
                f32x4 acc = {0.f, 0.f, 0.f, 0.f};
                const bf16* arow = XB + (row0 + 16 * tile + (lane & 15)) * DM + 512 * kh + 8 * (lane >> 4);
                const bf16* brow = Wab_t + (size_t)(lane & 7) * DM + 512 * kh + 8 * (lane >> 4);
                bf16x8 af[16], bfr[16];
#pragma unroll
                for (int s = 0; s < 16; ++s) { af[s] = *(const bf16x8*)(arow + 32 * s); bfr[s] = *(const bf16x8*)(brow + 32 * s); }
#pragma unroll
                for (int s = 0; s < 16; ++s) acc = __builtin_amdgcn_mfma_f32_16x16x32_bf16(af[s], bfr[s], acc, 0, 0, 0);
                LAS f32x4* red = (LAS f32x4*)lds;
                if (kh == 1) red[tile * 64 + lane] = acc;
                WG_BAR();
                if (kh == 0) {
                    acc += red[tile * 64 + lane];
                    const int col = lane & 15;
                    if (col < 8) { const int hd = col & 3; const float al = __expf(a_log[hd]), db = dt_bias[hd];
#pragma unroll
                        for (int j = 0; j < 4; ++j) { const size_t row = row0 + 16 * tile + 4 * (lane >> 4) + j; const float v = acc[j];
                            if (col < 4) { const float z = v + db; const float sp = fmaxf(z, 0.f) + log1pf(__expf(-fabsf(z))); GARR[row * 4 + hd] = -al * sp; }
                            else BARR[row * 4 + hd] = pg8::sigmoid_f(v); } }
                }
                WG_BAR();
            }
        }
        }
#endif
        for (int rs_ = 0; rs_ < REP_SYNC; ++rs_) xcd_barrier(xbar);

#ifndef SKIP_P3
        for (int rep_ = 0; rep_ < REP_P3; ++rep_)
        {
        {
            PH_BEGIN
            const float* conv_qkv = P.in[4] + Lq * 4 * 1536;
            LAS bf16* ks = (LAS bf16*)(lds + 0); LAS bf16* qs = (LAS bf16*)(lds + 17408); LAS bf16* kdT = (LAS bf16*)(lds + 34816);
            LAS bf16* vbT = (LAS bf16*)(lds + 53248); LAS bf16* kbeT = (LAS bf16*)(lds + 71680); LAS float* Lf = (LAS float*)(lds + 90112);
            LAS bf16* Ts = (LAS bf16*)(lds + 107520); LAS float* LfT = (LAS float*)(lds + 119808);     LAS float* gS = (LAS float*)(lds + 116736); LAS float* betaS = gS + 256; LAS float* gcS = gS + 512;
            for (int ub = bid; ub < NB * 32; ub += G) { const int unit = (ub & 7) * 32 + (ub >> 3);
                const int b = unit >> 5, n = unit & 31, t0 = n * 64; const size_t row0 = (size_t)b * SEQ + t0;
                if (tid < 256) { const int tok = tid >> 2, hd = tid & 3; gS[hd * 64 + tok] = GARR[(row0 + tok) * 4 + hd]; betaS[hd * 64 + tok] = BARR[(row0 + tok) * 4 + hd]; }
                WG_BAR();
                if (wave < 4) { float v = gS[wave * 64 + lane];
#pragma unroll
                    for (int o = 1; o < 64; o <<= 1) { const float t = __shfl_up(v, o); if (lane >= o) v += t; }
                    gcS[wave * 64 + lane] = v; }
                WG_BAR();
                for (int h = 0; h < 4; ++h) {
                    int tidh = tid; asm volatile("" : "+v"(tidh));
                    const int laneh = tidh & 63, r32h = laneh & 31, hhh = laneh >> 5;
                    const int item = (b * 4 + h) * 32 + n;
                    unsigned char* rec = REC + (size_t)item * REC_BYTES;
                    LAS float* cwS = (LAS float*)(lds + 137216);
                    for (int e = tidh; e < 1536; e += NTHREADS) cwS[e] = conv_qkv[((e >> 7) & 3) * 1536 + (e >> 9) * 512 + h * 128 + (e & 127)];
                    WG_BAR();
                    for (int ra_ = 0; ra_ < REP_SA; ++ra_) {
                        const int tk = tidh >> 3, cgp = tidh & 7; const int t = t0 + tk;
                        const float gcv = gcS[h * 64 + tk], btv = betaS[h * 64 + tk], glast = gcS[h * 64 + 63];
                        const float eg = __expf(gcv), egl = __expf(glast - gcv);
                        const int tkp = (tk & ~15) | swap23(tk & 15);
                        const int tkx = (((tk >> 3) ^ cgp) << 3) | (tk & 7), tkpx = (((tkp >> 3) ^ cgp) << 3) | (tkp & 7);
#pragma unroll
                        for (int part = 0; part < 3; ++part) {
                            const int colb = part * 512 + h * 128 + 16 * cgp;
                            float y[16];
#pragma unroll
                            for (int i = 0; i < 16; ++i) y[i] = 0.f;
#pragma unroll
                            for (int j = 0; j < 4; ++j) {
                                const int tt = t - 3 + j;
                                if (tt >= 0) {
                                    const u32x4* src = (const u32x4*)(PA + ((size_t)b * SEQ + tt) * PHALF + colb);
                                    const u32x4 x0 = src[0], x1 = src[1];
                                    const LAS f32x4* wv = (const LAS f32x4*)(cwS + (part * 4 + j) * 128 + 16 * cgp);
                                    const f32x4 w0 = wv[0], w1 = wv[1], w2 = wv[2], w3 = wv[3];
                                    y[0] += w0.x * bf_lo(x0.x); y[1] += w0.y * bf_hi(x0.x); y[2] += w0.z * bf_lo(x0.y); y[3] += w0.w * bf_hi(x0.y);
                                    y[4] += w1.x * bf_lo(x0.z); y[5] += w1.y * bf_hi(x0.z); y[6] += w1.z * bf_lo(x0.w); y[7] += w1.w * bf_hi(x0.w);
                                    y[8] += w2.x * bf_lo(x1.x); y[9] += w2.y * bf_hi(x1.x); y[10] += w2.z * bf_lo(x1.y); y[11] += w2.w * bf_hi(x1.y);
                                    y[12] += w3.x * bf_lo(x1.z); y[13] += w3.y * bf_hi(x1.z); y[14] += w3.z * bf_lo(x1.w); y[15] += w3.w * bf_hi(x1.w);
                                }
                            }
#pragma unroll
                            for (int i = 0; i < 16; ++i) y[i] = pg8::silu_f(y[i]);
                            if (part < 2) {
                                float ss = 0.f;
#pragma unroll
                                for (int i = 0; i < 16; ++i) ss += y[i] * y[i];
                                ss += __shfl_xor(ss, 1); ss += __shfl_xor(ss, 2); ss += __shfl_xor(ss, 4);
                                const float rinv = rsqrtf(ss + EPS) * (part == 0 ? 0.08838834764831845f : 1.f);
#pragma unroll
                                for (int i = 0; i < 16; ++i) y[i] *= rinv;
                            }
                            if (part == 0) {
                                u32x4 a0, a1;
                                a0.x = pk2(y[0], y[1]); a0.y = pk2(y[2], y[3]); a0.z = pk2(y[4], y[5]); a0.w = pk2(y[6], y[7]);
                                a1.x = pk2(y[8], y[9]); a1.y = pk2(y[10], y[11]); a1.z = pk2(y[12], y[13]); a1.w = pk2(y[14], y[15]);
                                *(LAS u32x4*)(qs + tk * 136 + 16 * cgp) = a0; *(LAS u32x4*)(qs + tk * 136 + 16 * cgp + 8) = a1;
                                u32x4 e0, e1;
                                e0.x = pk2(y[0] * eg, y[1] * eg); e0.y = pk2(y[2] * eg, y[3] * eg); e0.z = pk2(y[8] * eg, y[9] * eg); e0.w = pk2(y[10] * eg, y[11] * eg);
                                e1.x = pk2(y[4] * eg, y[5] * eg); e1.y = pk2(y[6] * eg, y[7] * eg); e1.z = pk2(y[12] * eg, y[13] * eg); e1.w = pk2(y[14] * eg, y[15] * eg);
                                u32x4* dst = (u32x4*)(rec + RO_QE + (tk * 136 + 16 * cgp) * 2); dst[0] = e0; dst[1] = e1;
                            } else if (part == 1) {
                                u32x4 a0, a1;
                                a0.x = pk2(y[0], y[1]); a0.y = pk2(y[2], y[3]); a0.z = pk2(y[4], y[5]); a0.w = pk2(y[6], y[7]);
                                a1.x = pk2(y[8], y[9]); a1.y = pk2(y[10], y[11]); a1.z = pk2(y[12], y[13]); a1.w = pk2(y[14], y[15]);
                                *(LAS u32x4*)(ks + tk * 136 + 16 * cgp) = a0; *(LAS u32x4*)(ks + tk * 136 + 16 * cgp + 8) = a1;
                                const float be = btv * eg;
#pragma unroll
                                for (int i = 0; i < 16; ++i) { kdT[(16 * cgp + i) * 72 + tkpx] = (bf16)f2bf(y[i] * egl); kbeT[(16 * cgp + i) * 72 + tkx] = (bf16)f2bf(y[i] * be); }
                            } else {
#pragma unroll
                                for (int i = 0; i < 16; ++i) vbT[(16 * cgp + i) * 72 + tkx] = (bf16)f2bf(y[i] * btv);
                            }
                        }
                    }
                    WG_BAR();
                    for (int rc_ = 0; rc_ < REP_SC; ++rc_) {
                        const int mat = wave >> 2, rt = (wave >> 1) & 1, ct = wave & 1;
                        f32x16 acc;
#pragma unroll
                        for (int i = 0; i < 16; ++i) acc[i] = 0.f;
                        if (!(rt == 0 && ct == 1)) {
                            const LAS bf16* Ab = (mat ? qs : ks) + (32 * rt + r32h) * 136 + 8 * hhh;
                            const LAS bf16* Bb = ks + (32 * ct + r32h) * 136 + 8 * hhh;
#pragma unroll
                            for (int s = 0; s < 8; ++s) { const bf16x8 a = *(const LAS bf16x8*)(Ab + 16 * s); const bf16x8 bb = *(const LAS bf16x8*)(Bb + 16 * s); acc = MFMA32(a, bb, acc); }
                        }
                        const int sc = 32 * ct + r32h; const float gs = gcS[h * 64 + sc];
                        const int scp = (sc & ~15) | swap23(sc & 15);
                        bf16* attn = (bf16*)(rec + RO_ATTN);
#pragma unroll
                        for (int g = 0; g < 4; ++g) {
                            const int cb = 32 * rt + 8 * g + 4 * hhh;
                            const f32x4 gcv = *(const LAS f32x4*)(gcS + h * 64 + cb), btv = *(const LAS f32x4*)(betaS + h * 64 + cb);
                            f32x4 lv4;
#pragma unroll
                            for (int e = 0; e < 4; ++e) { const int c = cb + e; const int i = 4 * g + e;
                                const float d = (sc <= c) ? __expf(gcv[e] - gs) : 0.f;
                                if (mat == 0) { const float lv = (sc < c) ? btv[e] * acc[i] * d : 0.f; Lf[c * 68 + sc] = lv; lv4[e] = lv; }
                                else attn[c * 72 + scp] = (bf16)f2bf(acc[i] * d); }
                            if (mat == 0) *(LAS f32x4*)(LfT + sc * 68 + cb) = lv4;
                        }
                    }
                    WG_BAR();
                    f32x16 Yacc;
#pragma unroll
                    for (int i = 0; i < 16; ++i) Yacc[i] = 0.f;
                    for (int rd_ = 0; rd_ < REP_SD; ++rd_)
                    if (wave < 2) {
                        const int blk = wave, col = laneh & 31;
                        float t[32];
                        const LAS float* Lfv = Lf + (32 * blk) * 68 + 32 * blk + col; asm volatile("" : "+v"(Lfv));
                        const LAS float* LTv = LfT + (32 * blk) * 68 + 32 * blk; asm volatile("" : "+v"(LTv));
                        t[0] = 0.f;
#pragma unroll
                        for (int c = 1; c < 32; ++c) t[c] = -Lfv[c * 68];
#define SUB_LOAD(buf, s) do { _Pragma("unroll") for (int g_ = ((s) + 1) >> 2; g_ < 8; ++g_) buf[g_] = *(const LAS f32x4*)(LTv + (s) * 68 + 4 * g_); } while (0)
#define SUB_FMA(buf, s) do { const float xs_ = t[s]; _Pragma("unroll") for (int g_ = ((s) + 1) >> 2; g_ < 8; ++g_) { \
        if (4 * g_ > (s)) t[4 * g_] -= buf[g_][0] * xs_; if (4 * g_ + 1 > (s)) t[4 * g_ + 1] -= buf[g_][1] * xs_; \
        if (4 * g_ + 2 > (s)) t[4 * g_ + 2] -= buf[g_][2] * xs_; if (4 * g_ + 3 > (s)) t[4 * g_ + 3] -= buf[g_][3] * xs_; } } while (0)
                        f32x4 la[8], lb[8];
                        SUB_LOAD(la, 1);
#pragma unroll
                        for (int s = 1; s < 31; s += 2) {
                            SUB_LOAD(lb, s + 1); __builtin_amdgcn_sched_barrier(0);
                            SUB_FMA(la, s); __builtin_amdgcn_sched_barrier(0);
                            if (s + 2 < 31) SUB_LOAD(la, s + 2);
                            __builtin_amdgcn_sched_barrier(0);
                            SUB_FMA(lb, s + 1); __builtin_amdgcn_sched_barrier(0);
                        }
#undef SUB_LOAD
#undef SUB_FMA
#pragma unroll
                        for (int c = 0; c < 32; ++c) Ts[(32 * blk + c) * 72 + 32 * blk + col] = (bf16)f2bf(t[c]);
                        asm volatile("s_waitcnt lgkmcnt(0)" ::: "memory");
                        Ts[(32 * blk + col) * 72 + 32 * blk + col] = (bf16)0x3F80;
                        if (blk == 0) {
#pragma unroll
                            for (int i = 0; i < 16; ++i) Yacc[i] = 0.f;
#pragma unroll
                            for (int kk = 0; kk < 2; ++kk) {
                                const LAS float* ap = Lf + (32 + r32h) * 68 + 16 * kk + 8 * hhh;
                                const f32x4 a0 = *(const LAS f32x4*)ap, a1 = *(const LAS f32x4*)(ap + 4);
                                u32x4 aw; aw.x = pk2(a0[0], a0[1]); aw.y = pk2(a0[2], a0[3]); aw.z = pk2(a1[0], a1[1]); aw.w = pk2(a1[2], a1[3]);
                                float bv[8];
#pragma unroll
                                for (int j = 0; j < 8; ++j) { float lo = t[16 * kk + j], hi = t[16 * kk + 8 + j]; asm volatile("" : "+v"(lo), "+v"(hi));
                                    const int rowk = 16 * kk + 8 * hhh + j; bv[j] = (hhh ? hi : lo) + ((rowk == col) ? 1.f : 0.f); }
                                u32x4 bw; bw.x = pk2(bv[0], bv[1]); bw.y = pk2(bv[2], bv[3]); bw.z = pk2(bv[4], bv[5]); bw.w = pk2(bv[6], bv[7]);
                                Yacc = MFMA32(__builtin_bit_cast(bf16x8, aw), __builtin_bit_cast(bf16x8, bw), Yacc);
                            }
                        }
                    } else {
                        for (int p = tidh - 128; p < 1152; p += NTHREADS - 128) *(u32x4*)(rec + RO_KDT + 16 * p) = *(const LAS u32x4*)((LAS unsigned char*)kdT + 16 * p);
                    }
                    WG_BAR();
                    if (wave == 0) {
                        f32x16 acc2;
#pragma unroll
                        for (int i = 0; i < 16; ++i) acc2[i] = 0.f;
#pragma unroll
                        for (int s = 0; s < 2; ++s) {
                            const LAS bf16* ap = Ts + (32 + r32h) * 72 + 32 + 16 * s + 4 * hhh;
                            const u32x2 q0 = *(const LAS u32x2*)ap, q1 = *(const LAS u32x2*)(ap + 8);
                            u32x4 aw; aw.x = q0.x; aw.y = q0.y; aw.z = q1.x; aw.w = q1.y;
                            acc2 = MFMA32(__builtin_bit_cast(bf16x8, aw), pack_step(Yacc, s), acc2);
                        }
#pragma unroll
                        for (int i = 0; i < 16; ++i) Ts[(32 + crow(i, hhh)) * 72 + r32h] = (bf16)f2bf(-acc2[i]);
                    }
                    WG_BAR();
                    for (int re_ = 0; re_ < REP_SE; ++re_) {
                        const int mat = wave >> 2, ct = wave & 3;
                        const LAS bf16* Bsrc = (mat ? kbeT : vbT) + (32 * ct + r32h) * 72 + 8 * (hhh ^ (r32h >> 4));
#pragma unroll
                        for (int rt = 0; rt < 2; ++rt) {
                            f32x16 acc;
#pragma unroll
                            for (int i = 0; i < 16; ++i) acc[i] = 0.f;
#pragma unroll
                            for (int s = 0; s < 4; ++s) if (s < 2 * (rt + 1)) { const bf16x8 a = *(const LAS bf16x8*)(Ts + (32 * rt + r32h) * 72 + 16 * s + 8 * hhh); const bf16x8 bb = *(const LAS bf16x8*)(Bsrc + 16 * (s ^ ct)); acc = MFMA32(a, bb, acc); }
                            if (mat == 0) { f32x4* up = (f32x4*)(UB + (((size_t)item * 4 + ct) * 2 + rt) * 1024) + laneh;
#pragma unroll
                                for (int q = 0; q < 4; ++q) up[q * 64] = (f32x4){acc[4 * q], acc[4 * q + 1], acc[4 * q + 2], acc[4 * q + 3]};
                            } else { bf16* nw = (bf16*)(rec + RO_NEGW); const int d = 32 * ct + r32h; const int dp = (d & ~15) | swap23(d & 15);
#pragma unroll
                                for (int i = 0; i < 16; ++i) nw[(32 * rt + crow(i, hhh)) * 136 + dp] = (bf16)f2bf(-acc[i]);
                            }
                        }
                        if (tidh == 0) GL[item] = __expf(gcS[h * 64 + 63]);
                    }
                    WG_BAR();
                }
            }
        }
        }
#endif
        for (int rs_ = 0; rs_ < REP_SYNC; ++rs_) xcd_barrier(xbar);

#ifndef SKIP_P4
        for (int rep_ = 0; rep_ < REP_P4; ++rep_)
        {
        {
            PH_BEGIN
            const float* pool_w = P.in[8] + Lq * 4 * 64 * 64; const float* pool_scale = P.in[9] + Lq * 256; const float* sconv_w = P.in[10] + Lq * 3 * 256;
            const int nscan = NB * 4;
#ifndef SKIP_SCAN
            for (int rsc_ = 0; rsc_ < REP_SCAN; ++rsc_)
            if (bid < nscan || G <= nscan) {
                for (int bq = bid; bq < nscan; bq += G) { const int bh = (bq & 7) * 4 + (bq >> 3);
                    const int b = bh >> 2, h = bh & 3;
                    const unsigned char* rec0 = REC + (size_t)(bh * 32) * REC_BYTES;
                    for (int p = tid; p < REC_BYTES / 16; p += NTHREADS) *(LAS u32x4*)(lds + 16 * p) = *(const u32x4*)(rec0 + 16 * p);
                    WG_BAR();
                    f32x16 S[4];
#pragma unroll
                    for (int t = 0; t < 4; ++t)
#pragma unroll
                        for (int i = 0; i < 16; ++i) S[t][i] = 0.f;
                    if (wave >= 4) {
                        const int t2 = tid - 256; const int fo = (t2 >> 4) * 4096 + (t2 & 15) * 16;
                        const unsigned char* rg = rec0 + fo; LAS unsigned char* l0 = lds + fo;
                        u32x4 RA[16], RB[16], RC[16];
#define SC_LD(R, k) do { const int k_ = ((k) < 32) ? (k) : 31; const unsigned char* rn_ = rg + (size_t)k_ * REC_BYTES; _Pragma("unroll") for (int i = 0; i < 16; ++i) R[i] = *(const u32x4*)(rn_ + 256 * i); } while (0)
#define SC_ST(R, k) do { LAS unsigned char* ln_ = l0 + ((k) & 1) * REC_BYTES; _Pragma("unroll") for (int i = 0; i < 16; ++i) { if (fo + 256 * i < REC_BYTES) *(LAS u32x4*)(ln_ + 256 * i) = R[i]; } } while (0)
                        SC_LD(RA, 1); SC_LD(RB, 2);
                        for (int n = 0; n < 30; n += 3) {
                            SC_LD(RC, n + 3); SC_ST(RA, n + 1); WG_BAR();
                            SC_LD(RA, n + 4); SC_ST(RB, n + 2); WG_BAR();
                            SC_LD(RB, n + 5); SC_ST(RC, n + 3); WG_BAR();
                        }
                        SC_ST(RA, 31); WG_BAR();
                        WG_BAR();
#undef SC_LD
#undef SC_ST
                    } else {
                        const int ct = wave;
                        f32x16 avn[2];
                        const float decall = GL[bh * 32 + (lane & 31)];
                        { const f32x4* up = (const f32x4*)(UB + (((size_t)(bh * 32) * 4 + ct) * 2) * 1024) + lane;
#pragma unroll
                          for (int rt = 0; rt < 2; ++rt)
#pragma unroll
                            for (int q = 0; q < 4; ++q) { const f32x4 v = up[rt * 256 + q * 64]; avn[rt][4 * q] = v[0]; avn[rt][4 * q + 1] = v[1]; avn[rt][4 * q + 2] = v[2]; avn[rt][4 * q + 3] = v[3]; }
                        }
                        for (int n = 0; n < 32; ++n) {
                            LAS unsigned char* cur = lds + (n & 1) * REC_BYTES;
                            f32x16 av[2], ao[2];
#pragma unroll
                            for (int rt = 0; rt < 2; ++rt)
#pragma unroll
                                for (int i = 0; i < 16; ++i) { av[rt][i] = avn[rt][i]; ao[rt][i] = 0.f; }
                            const float dec = __int_as_float(__builtin_amdgcn_readlane(__float_as_int(decall), n));
                            { const int nn = (n < 31) ? n + 1 : 31;
                              const f32x4* up = (const f32x4*)(UB + (((size_t)(bh * 32 + nn) * 4 + ct) * 2) * 1024) + lane;
#pragma unroll
                              for (int rt = 0; rt < 2; ++rt)
#pragma unroll
                                for (int q = 0; q < 4; ++q) { const f32x4 v = up[rt * 256 + q * 64]; avn[rt][4 * q] = v[0]; avn[rt][4 * q + 1] = v[1]; avn[rt][4 * q + 2] = v[2]; avn[rt][4 * q + 3] = v[3]; }
                            }
                            const LAS bf16* fA = (const LAS bf16*)(cur + RO_NEGW) + r32 * 136 + 8 * hh;
                            const LAS bf16* fK = (const LAS bf16*)(cur + RO_KDT) + r32 * 72 + 8 * (hh ^ (r32 >> 4));
                            const LAS bf16* fT = (const LAS bf16*)(cur + RO_ATTN) + r32 * 72 + 8 * hh;
#define SC_LDF(f, kk) do { f[0] = *(const LAS bf16x8*)(fA + 16 * (kk)); f[1] = *(const LAS bf16x8*)(fA + 32 * 136 + 16 * (kk)); \
                           f[2] = *(const LAS bf16x8*)(fA + RO_QE / 2 + 16 * (kk)); f[3] = *(const LAS bf16x8*)(fA + RO_QE / 2 + 32 * 136 + 16 * (kk)); } while (0)
#define SC_MM(f, kk) do { const bf16x8 sb_ = pack_step(S[(kk) >> 1], (kk) & 1); \
                          av[0] = MFMA32(f[0], sb_, av[0]); av[1] = MFMA32(f[1], sb_, av[1]); ao[0] = MFMA32(f[2], sb_, ao[0]); ao[1] = MFMA32(f[3], sb_, ao[1]); } while (0)
                            bf16x8 fa[4], fb[4], ft[6];
                            __builtin_amdgcn_sched_barrier(0);
                            SC_LDF(fa, 0);
#pragma unroll
                            for (int kk = 0; kk < 8; kk += 2) {
                                SC_LDF(fb, kk + 1); __builtin_amdgcn_sched_barrier(0);
                                SC_MM(fa, kk); __builtin_amdgcn_sched_barrier(0);
                                if (kk + 2 < 8) SC_LDF(fa, kk + 2);
                                else { ft[0] = *(const LAS bf16x8*)(fT); ft[1] = *(const LAS bf16x8*)(fT + 16); ft[2] = *(const LAS bf16x8*)(fT + 32 * 72);
                                       ft[3] = *(const LAS bf16x8*)(fT + 32 * 72 + 16); ft[4] = *(const LAS bf16x8*)(fT + 32 * 72 + 32); ft[5] = *(const LAS bf16x8*)(fT + 32 * 72 + 48); }
                                __builtin_amdgcn_sched_barrier(0);
                                SC_MM(fb, kk + 1); __builtin_amdgcn_sched_barrier(0);
                            }
#undef SC_LDF
#undef SC_MM
                            bf16x8 vb[4];
#pragma unroll
                            for (int rt = 0; rt < 2; ++rt) { vb[2 * rt] = pack_step(av[rt], 0); vb[2 * rt + 1] = pack_step(av[rt], 1); }
#define SC_LDK(f, t) do { f[0] = *(const LAS bf16x8*)(fK + (32 * (t)) * 72 + 16 * (0 ^ (t))); f[1] = *(const LAS bf16x8*)(fK + (32 * (t)) * 72 + 16 * (1 ^ (t))); \
                           f[2] = *(const LAS bf16x8*)(fK + (32 * (t)) * 72 + 16 * (2 ^ (t))); f[3] = *(const LAS bf16x8*)(fK + (32 * (t)) * 72 + 16 * (3 ^ (t))); } while (0)
#define SC_MK(f, t) do { _Pragma("unroll") for (int i = 0; i < 16; ++i) S[t][i] *= dec; \
                          S[t] = MFMA32(f[0], vb[0], S[t]); S[t] = MFMA32(f[1], vb[1], S[t]); S[t] = MFMA32(f[2], vb[2], S[t]); S[t] = MFMA32(f[3], vb[3], S[t]); } while (0)
                            SC_LDK(fa, 0);
                            __builtin_amdgcn_sched_barrier(0);
                            ao[0] = MFMA32(ft[0], vb[0], ao[0]); ao[0] = MFMA32(ft[1], vb[1], ao[0]);
                            ao[1] = MFMA32(ft[2], vb[0], ao[1]); ao[1] = MFMA32(ft[3], vb[1], ao[1]); ao[1] = MFMA32(ft[4], vb[2], ao[1]); ao[1] = MFMA32(ft[5], vb[3], ao[1]);
                            __builtin_amdgcn_sched_barrier(0);
                            SC_LDK(fb, 1); __builtin_amdgcn_sched_barrier(0);
                            SC_MK(fa, 0); __builtin_amdgcn_sched_barrier(0);
                            SC_LDK(fa, 2); __builtin_amdgcn_sched_barrier(0);
                            SC_MK(fb, 1); __builtin_amdgcn_sched_barrier(0);
                            SC_LDK(fb, 3); __builtin_amdgcn_sched_barrier(0);
                            SC_MK(fa, 2); __builtin_amdgcn_sched_barrier(0);
                            {
                                unsigned char* obase = (unsigned char*)(OB + ((size_t)b * SEQ + 64 * n) * 512 + h * 128);
                                unsigned off0 = (unsigned)((4 * hh * 512 + 32 * ct + r32) * 4); asm volatile("" : "+v"(off0));
#pragma unroll
                                for (int rt = 0; rt < 2; ++rt)
#pragma unroll
                                    for (int i = 0; i < 16; ++i) *(float*)(obase + (off0 + (unsigned)((32 * rt + (i & 3) + 8 * (i >> 2)) * 2048))) = ao[rt][i];
                            }
                            __builtin_amdgcn_sched_barrier(0);
                            SC_MK(fb, 3); __builtin_amdgcn_sched_barrier(0);
#undef SC_LDK
#undef SC_MK
                            WG_BAR();
                        }
                    }
                    WG_BAR();
                }
            }
#endif
#ifndef SKIP_MIX
            for (int rmx_ = 0; rmx_ < REP_MIX; ++rmx_)
            {
                const int nmix = (G > nscan) ? G - nscan : G; const int mixid = (G > nscan) ? bid - nscan : bid;
                if (mixid >= 0) {
                    LAS bf16* pooledS = (LAS bf16*)(lds + 0);
                    LAS bf16* WTs = (LAS bf16*)(lds + 33792);
                    for (int i = tid; i < 4 * 64 * 64; i += NTHREADS) { const int g = i >> 12, c = (i >> 6) & 63, d = i & 63; WTs[(g * 64 + d) * 72 + c] = (bf16)f2bf(pool_w[i]); }
                    for (int uj = mixid >> 3; uj < 32; uj += (nmix >> 3)) { const int unit = (bid & 7) * 32 + uj;
                        const size_t urow0 = (size_t)unit * 64; const int t0 = (int)(urow0 % SEQ);
                        const int tk = tid >> 3, sub = tid & 7; const int t = t0 + tk; const size_t row = urow0 + tk;
                        WG_BAR();
                        {
                            LAS bf16* poolS = (LAS bf16*)(lds + 70656);
                            for (int p = tid; p < 79 * 32; p += NTHREADS) { const int rr = p >> 5, cc = p & 31; const int tt = t0 - 15 + rr;
                                u32x4 v = {0u, 0u, 0u, 0u}; if (tt >= 0) v = *(const u32x4*)(PB + (urow0 - 15 + rr) * PHALF + 512 + 8 * cc);
                                *(LAS u32x4*)(poolS + rr * 264 + 8 * cc) = v; }
                            WG_BAR();
                            const int win = 2 << (sub >> 1);
                            float sum[32];
#pragma unroll
                            for (int i = 0; i < 32; ++i) sum[i] = 0.f;
                            for (int j = 0; j < win; ++j) {
                                const LAS u32x4* src = (const LAS u32x4*)(poolS + (tk + 15 - j) * 264 + 32 * sub);
#pragma unroll
                                for (int q = 0; q < 4; ++q) { const u32x4 xv = src[q];
                                    sum[8 * q + 0] += bf_lo(xv.x); sum[8 * q + 1] += bf_hi(xv.x); sum[8 * q + 2] += bf_lo(xv.y); sum[8 * q + 3] += bf_hi(xv.y);
                                    sum[8 * q + 4] += bf_lo(xv.z); sum[8 * q + 5] += bf_hi(xv.z); sum[8 * q + 6] += bf_lo(xv.w); sum[8 * q + 7] += bf_hi(xv.w); }
                            }
                            const float inv = 1.f / (float)((t + 1 < win) ? (t + 1) : win);
#pragma unroll
                            for (int q = 0; q < 4; ++q) { u32x4 w; const u32x4 sv = ((const LAS u32x4*)(poolS + (tk + 15) * 264 + 32 * sub))[q];
                                w.x = pk2(sum[8 * q + 0] * inv - bf_lo(sv.x), sum[8 * q + 1] * inv - bf_hi(sv.x)); w.y = pk2(sum[8 * q + 2] * inv - bf_lo(sv.y), sum[8 * q + 3] * inv - bf_hi(sv.y));
                                w.z = pk2(sum[8 * q + 4] * inv - bf_lo(sv.z), sum[8 * q + 5] * inv - bf_hi(sv.z)); w.w = pk2(sum[8 * q + 6] * inv - bf_lo(sv.w), sum[8 * q + 7] * inv - bf_hi(sv.w));
                                *(LAS u32x4*)(pooledS + tk * 264 + 32 * sub + 8 * q) = w; }
                        }
                        {
                            float acc[32];
#pragma unroll
                            for (int i = 0; i < 32; ++i) acc[i] = 0.f;
#pragma unroll
                            for (int j = 0; j < 3; ++j) {
                                if (t - 2 + j >= 0) {
                                    const u32x4* sc = (const u32x4*)(PB + (row - 2 + j) * PHALF + 1024 + 32 * sub); const u32x4* sh = (const u32x4*)(PB + (row - 2 + j) * PHALF + 1280 + 32 * sub);
                                    const f32x4* wv = (const f32x4*)(sconv_w + j * 256 + 32 * sub);
#pragma unroll
                                    for (int q = 0; q < 4; ++q) { const u32x4 c4 = sc[q], h4 = sh[q]; const f32x4 w0 = wv[2 * q], w1 = wv[2 * q + 1];
                                        acc[8 * q + 0] += w0.x * bf_lo(c4.x) * bf_lo(h4.x); acc[8 * q + 1] += w0.y * bf_hi(c4.x) * bf_hi(h4.x); acc[8 * q + 2] += w0.z * bf_lo(c4.y) * bf_lo(h4.y); acc[8 * q + 3] += w0.w * bf_hi(c4.y) * bf_hi(h4.y);
                                        acc[8 * q + 4] += w1.x * bf_lo(c4.z) * bf_lo(h4.z); acc[8 * q + 5] += w1.y * bf_hi(c4.z) * bf_hi(h4.z); acc[8 * q + 6] += w1.z * bf_lo(c4.w) * bf_lo(h4.w); acc[8 * q + 7] += w1.w * bf_hi(c4.w) * bf_hi(h4.w); }
                                }
                            }
                            const u32x4* sb = (const u32x4*)(PB + row * PHALF + 768 + 32 * sub);
                            u32x4* dst = (u32x4*)(HB + row * DM + 768 + 32 * sub);
#pragma unroll
                            for (int q = 0; q < 4; ++q) { const u32x4 b4 = sb[q]; u32x4 w;
                                w.x = pk2(acc[8 * q + 0] * bf_lo(b4.x), acc[8 * q + 1] * bf_hi(b4.x)); w.y = pk2(acc[8 * q + 2] * bf_lo(b4.y), acc[8 * q + 3] * bf_hi(b4.y));
                                w.z = pk2(acc[8 * q + 4] * bf_lo(b4.z), acc[8 * q + 5] * bf_hi(b4.z)); w.w = pk2(acc[8 * q + 6] * bf_lo(b4.w), acc[8 * q + 7] * bf_hi(b4.w));
                                dst[q] = w; }
                        }
                        WG_BAR();
                        {
                            const int g = wave >> 1, rt = wave & 1;
#pragma unroll
                            for (int ct = 0; ct < 2; ++ct) {
                                f32x16 acc;
#pragma unroll
                                for (int i = 0; i < 16; ++i) acc[i] = 0.f;
#pragma unroll
                                for (int s = 0; s < 4; ++s) { const bf16x8 a = *(const LAS bf16x8*)(pooledS + (32 * rt + r32) * 264 + 64 * g + 16 * s + 8 * hh);
                                    const bf16x8 bb = *(const LAS bf16x8*)(WTs + (g * 64 + 32 * ct + r32) * 72 + 16 * s + 8 * hh); acc = MFMA32(a, bb, acc); }
                                const int d = 64 * g + 32 * ct + r32; const float psc = pool_scale[d];
#pragma unroll
                                for (int i = 0; i < 16; ++i) HB[(urow0 + 32 * rt + crow(i, hh)) * DM + 512 + d] = (bf16)f2bf(acc[i] * psc);
                            }
                        }
                    }
                    {
                        WG_BAR();
                        const float* w_out = P.in[11] + (size_t)Lq * DM * DM;
                        const float* w_gate = P.in[13] + (size_t)Lq * DM * DFF; const float* w_up = P.in[14] + (size_t)Lq * DM * DFF; const float* w_down = P.in[15] + (size_t)Lq * DFF * DM;
                        const float* ple_proj = P.in[16] + (size_t)Lq * PLE * DM; const float* ple_gate = P.in[17] + (size_t)Lq * DM * DM;
                        LAS float* scr = (LAS float*)(lds + wave * 8448);
                        constexpr int I_OUT = 16 * 32, I_GU = 16 * 176, I_DOWN = 44 * 32, I_PG = 16 * 32, I_PP = 4 * 32;
                        constexpr int NITEMS = I_OUT + I_GU + I_DOWN + I_PG + I_PP;
                        const int nextra = (M / 64 > nmix && M / 64 - nmix < nmix) ? (M / 64 - nmix) : 0; const int nconv = nmix - nextra, convid = mixid - nextra;
                        if (convid >= 0)
                        for (int it = convid * NWAVES + wave; it < NITEMS; it += nconv * NWAVES) {
                            int r = it;
                            if (r < I_OUT) { const int kb = r / 32, nb = r % 32; transpose_item(w_out, DM, 64 * kb, 32 * nb, Wout_t, DM, 32 * nb, scr, lane); continue; } r -= I_OUT;
                            if (r < I_GU) { const int kb = r / 176, nb = r % 176; const int pn = nb >> 3, wi = nb & 7; const float* src = (wi < 4) ? w_gate : w_up;
                                transpose_item(src, DFF, 64 * kb, 128 * pn + 32 * (wi & 3), Wgu_t, DM, 32 * nb, scr, lane); continue; } r -= I_GU;
                            if (r < I_DOWN) { const int kb = r / 32, nb = r % 32; transpose_item(w_down, DM, 64 * kb, 32 * nb, Wdown_t, DFF, 32 * nb, scr, lane); continue; } r -= I_DOWN;
                            if (r < I_PG) { const int kb = r / 32, nb = r % 32; transpose_item(ple_gate, DM, 64 * kb, 32 * nb, Wpg_t, DM, 32 * nb, scr, lane); continue; } r -= I_PG;
                            { const int kb = r / 32, nb = r % 32; transpose_item(ple_proj, DM, 64 * kb, 32 * nb, Wpp_t, PLE, 32 * nb, scr, lane); }
                        }
                    }
                }
            }
#endif
        }
        }
#endif
        for (int rs_ = 0; rs_ < REP_SYNC; ++rs_) xcd_barrier(xbar);

#ifndef SKIP_P5
        for (int rep_ = 0; rep_ < REP_P5; ++rep_)
        {
        {
        PH_BEGIN
        const float* onorm_g = P.in[7] + Lq * 128; const float* p_in = P.in[1] + (size_t)Lq * M * PLE;
        if (Lq + 1 < DEPTH) {
            const float* w_in_n = P.in[3] + (size_t)(Lq + 1) * DM * DIN; LAS float* scr = (LAS float*)(lds + wave * 8448);
            for (int it = gw; it < 16 * 96; it += NGW) { const int kb = it / 96, nb = it % 96; const int d0 = 32 * nb; transpose_item(w_in_n, DIN, 64 * kb, d0 < 2048 ? d0 : d0 + 8, Win_t, DM, d0, scr, lane); }
            for (int i = gt; i < 8 * DM; i += NGT) { const int n = i >> 10, k = i & 1023; Wab_t[n * DM + k] = (bf16)f2bf(w_in_n[(size_t)k * DIN + 2048 + n]); }
        }
        for (int i = gt; i < M * PLE / 8; i += NGT) { const f32x4 a = ((const f32x4*)p_in)[2 * i], c = ((const f32x4*)p_in)[2 * i + 1]; ((u32x4*)PBF)[i] = pg8::pack8(a, c); }
        for (int ii = (bid >> 3) * NTHREADS + tid; ii < SEQ * 32; ii += (G >> 3) * NTHREADS) { const int idx = (bid & 7) * (SEQ * 32) + ii;
            const int row = idx >> 5, h = (idx >> 3) & 3, cgp = idx & 7;
            const f32x4* op = (const f32x4*)(OB + (size_t)row * 512 + h * 128 + 16 * cgp);
            const f32x4 o0 = op[0], o1 = op[1], o2 = op[2], o3 = op[3];
            float ss = (o0.x * o0.x + o0.y * o0.y + o0.z * o0.z + o0.w * o0.w) + (o1.x * o1.x + o1.y * o1.y + o1.z * o1.z + o1.w * o1.w)
                     + (o2.x * o2.x + o2.y * o2.y + o2.z * o2.z + o2.w * o2.w) + (o3.x * o3.x + o3.y * o3.y + o3.z * o3.z + o3.w * o3.w);
            ss += __shfl_xor(ss, 1); ss += __shfl_xor(ss, 2); ss += __shfl_xor(ss, 4);
            const float rstd = rsqrtf(ss * (1.f / 128.f) + EPS);
            const u32x4* zp = (const u32x4*)(PB + (size_t)row * PHALF + h * 128 + 16 * cgp); const u32x4 z0 = zp[0], z1 = zp[1];
            const f32x4* gp = (const f32x4*)(onorm_g + 16 * cgp); const f32x4 g0 = gp[0], g1 = gp[1], g2 = gp[2], g3 = gp[3];
            u32x4 w0, w1;
            w0.x = pk2(o0.x * rstd * g0.x * pg8::silu_f(bf_lo(z0.x)), o0.y * rstd * g0.y * pg8::silu_f(bf_hi(z0.x))); w0.y = pk2(o0.z * rstd * g0.z * pg8::silu_f(bf_lo(z0.y)), o0.w * rstd * g0.w * pg8::silu_f(bf_hi(z0.y)));
            w0.z = pk2(o1.x * rstd * g1.x * pg8::silu_f(bf_lo(z0.z)), o1.y * rstd * g1.y * pg8::silu_f(bf_hi(z0.z))); w0.w = pk2(o1.z * rstd * g1.z * pg8::silu_f(bf_lo(z0.w)), o1.w * rstd * g1.w * pg8::silu_f(bf_hi(z0.w)));
            w1.x = pk2(o2.x * rstd * g2.x * pg8::silu_f(bf_lo(z1.x)), o2.y * rstd * g2.y * pg8::silu_f(bf_hi(z1.x))); w1.y = pk2(o2.z * rstd * g2.z * pg8::silu_f(bf_lo(z1.y)), o2.w * rstd * g2.w * pg8::silu_f(bf_hi(z1.y)));
            w1.z = pk2(o3.x * rstd * g3.x * pg8::silu_f(bf_lo(z1.z)), o3.y * rstd * g3.y * pg8::silu_f(bf_hi(z1.z))); w1.w = pk2(o3.z * rstd * g3.z * pg8::silu_f(bf_lo(z1.w)), o3.w * rstd * g3.w * pg8::silu_f(bf_hi(z1.w)));
            u32x4* dst = (u32x4*)(HB + (size_t)row * DM + h * 128 + 16 * cgp); dst[0] = w0; dst[1] = w1;
        }
        }
        }
#endif
        for (int rs_ = 0; rs_ < REP_SYNC; ++rs_) xcd_barrier(xbar);

#ifndef SKIP_P6
        {
            PH_BEGIN
            const float* xin = (Lq == 0) ? P.in[0] : XRES;
            pg8::Gemm g{HB, Wout_t, M, DM, DM}; pg8::StaticOrder S; S.init(M, DM, G, bid);
            const float* norm2_g = P.in[12] + Lq * DM;
            pg8::EpiNorm<0> E{xin, XRES, nullptr, XB, norm2_g, XCH(2 * Lq), XCNT(2 * Lq), nullptr};
            pg8::gemm_phase<pg8::EpiNorm<0>, pg8::StaticOrder, false, true>(lds, g, S, E);
        }
#endif
        for (int rs_ = 0; rs_ < REP_SYNC; ++rs_) xcd_barrier(xbar);

#ifndef SKIP_P8
        for (int rep_ = 0; rep_ < REP_P8; ++rep_)
        {
        {
            PH_BEGIN
            { pg8::Gemm g{XB, Wgu_t, M, 2 * DFF, DM}; pg8::StaticOrder S; S.init(M, 2 * DFF, G, bid);
              pg8::EpiSwiglu E{FF, DFF};
              pg8::gemm_phase<pg8::EpiSwiglu, pg8::StaticOrder, true, true>(lds, g, S, E); }
            {
                const int nfull = (64 * 22) % G; const int G2 = (nfull > 0) ? G - nfull : G; const int c2 = (nfull > 0) ? bid - nfull : bid;
                pg8::Gemm g{PBF, Wpp_t, M, DM, PLE}; pg8::StaticOrder S; S.init(M, DM, G2, c2 >= 0 ? c2 : (1 << 28));
                pg8::EpiBf16S E{PP, PP, DM, 1 << 30};
                pg8::gemm_phase<pg8::EpiBf16S, pg8::StaticOrder, true, true>(lds, g, S, E); }
        }
        }
#endif
        for (int rs_ = 0; rs_ < REP_SYNC; ++rs_) xcd_barrier(xbar);

#ifndef SKIP_P9
        {
            { PH_BEGIN
              pg8::Gemm g{FF, Wdown_t, M, DM, DFF}; pg8::StaticOrder S; S.init(M, DM, G, bid);
              pg8::EpiRes E{XRES, nullptr, HB};
              pg8::gemm_phase<pg8::EpiRes, pg8::StaticOrder, ALIGN1, true>(lds, g, S, E); }
        }
#endif
        for (int rs_ = 0; rs_ < REP_SYNC; ++rs_) xcd_barrier(xbar);

#ifndef SKIP_P10
        {
            PH_BEGIN
            pg8::Gemm g{HB, Wpg_t, M, DM, DM}; pg8::StaticOrder S; S.init(M, DM, G, bid);
            if (Lq + 1 < DEPTH) {
                const float* g1n = P.in[2] + (Lq + 1) * DM;
                pg8::EpiNorm<1> E{XRES, XRES, PP, XB, g1n, XCH(2 * Lq + 1), XCNT(2 * Lq + 1), HB};
                pg8::gemm_phase<pg8::EpiNorm<1>, pg8::StaticOrder, false, true>(lds, g, S, E);
            } else {
                pg8::EpiNorm<2> E{XRES, XRES, PP, nullptr, P.in[18], XCH(2 * Lq + 1), XCNT(2 * Lq + 1), HB};
                pg8::gemm_phase<pg8::EpiNorm<2>, pg8::StaticOrder, false, true>(lds, g, S, E);
            }
        }
#endif
        if (L + 1 < DEPTH) { for (int rs_ = 0; rs_ < REP_SYNC; ++rs_) xcd_barrier(xbar); }
    }
}

extern "C" void kernel_launch(void* const* d_in, const int* in_sizes, int n_in, void* d_out, int out_size, void* d_ws, size_t ws_size, hipStream_t stream) {
    static int grid = 0;
    if (grid == 0) {
        if (n_in != 19 || out_size != M * DM || ws_size < WS_END) { fprintf(stderr, "kernel_launch: unexpected shapes (n_in %d out %d ws %zu)\n", n_in, out_size, ws_size); grid = -1; return; }
        int dev = 0, cus = 0, per_cu = 0;
        hipGetDevice(&dev);
        hipDeviceGetAttribute(&cus, hipDeviceAttributeMultiprocessorCount, dev);
        hipFuncSetAttribute((const void*)fwd_kernel, hipFuncAttributeMaxDynamicSharedMemorySize, LDS_BYTES);
        hipOccupancyMaxActiveBlocksPerMultiprocessor(&per_cu, (const void*)fwd_kernel, NTHREADS, LDS_BYTES);
        if (per_cu < 1) { fprintf(stderr, "kernel_launch: occupancy query says %d blocks per CU\n", per_cu); per_cu = 1; }
        if (per_cu > 1) per_cu = 1;
        grid = cus * per_cu;
        if (grid != 256) { fprintf(stderr, "kernel_launch: built for a 256-workgroup grid (one 256x256 unit per workgroup in the fused-norm phases), got %d; nothing launched\n", grid); grid = -1; return; }
        (void)hipGetLastError();
    }
    if (grid < 0) return;
    if (hipMemsetAsync(d_ws, 0, 131072, stream) != hipSuccess) { fprintf(stderr, "kernel_launch: memset of the barrier words failed\n"); return; }
    Params p{};
    for (int i = 0; i < 19; ++i) p.in[i] = (const float*)d_in[i];
    p.out = (float*)d_out; p.ws = (unsigned char*)d_ws;
    void* args[] = {&p};
    hipError_t e = hipLaunchCooperativeKernel((const void*)fwd_kernel, dim3(grid), dim3(NTHREADS), args, LDS_BYTES, stream);
    if (e != hipSuccess) fprintf(stderr, "cooperative launch failed: %s (grid %d)\n", hipGetErrorString(e), grid);
}
```

```cpp
#include <hip/hip_runtime.h>
#include <hip/hip_cooperative_groups.h>
#include <cstdio>
#include <cstdint>
namespace cg = cooperative_groups;
namespace pg8 {
#define PG8_LAS __attribute__((address_space(3)))
typedef unsigned short bf16_t;
typedef short bf16x8 __attribute__((ext_vector_type(8)));
typedef float f32x4 __attribute__((ext_vector_type(4)));
typedef unsigned u32x4 __attribute__((ext_vector_type(4)));
constexpr int BM = 256, BK = 64, HALF = 128, HTB = HALF * BK * 2  , STAGE_BYTES = 8 * HTB, NXCD = 8, WGM = 8;

__host__ __device__ __forceinline__ int lds_byte(int r, int c) { const int st = (r >> 4) * 2 + (c >> 5), rr = r & 15, cc = c & 31, ob = rr * 64 + cc * 2; return st * 1024 + (ob ^ (((ob >> 9) & 1) << 5)); }
__host__ __device__ __forceinline__ void stage_rc(int b, int& R, int& C) { const int st = b / 1024, sb = b % 1024, swz = sb ^ (((sb >> 9) & 1) << 5); R = (st >> 1) * 16 + swz / 64; C = (st & 1) * 32 + (swz % 64) / 2; }
__host__ __device__ __forceinline__ int perm32(int rho) { const int n = rho >> 4, i = rho & 15; return 8 * (i >> 2) + 4 * n + (i & 3); }

struct Unit { int pm, pn; };
struct Gemm { const bf16_t* A; const bf16_t* Bt; int M, N, K; };

struct StaticOrder {
    int nM, nN, nwg, G, c;
    __host__ __device__ void init(int M, int N, int G_, int c_) { nM = M / BM; nN = N / BM; nwg = nM * nN; G = G_; c = c_; }
    __host__ __device__ bool next(int i, Unit& u) const {
        const long L = (long)i * G + c; if (L >= nwg) return false;
        int wgid = (int)L; { const int q = nwg / NXCD, r = nwg % NXCD, xcd = wgid % NXCD, off = wgid / NXCD; wgid = (xcd < r ? xcd * (q + 1) : r * (q + 1) + (xcd - r) * q) + off; }
        const int nig = WGM * nN, gid = wgid / nig, fm = gid * WGM, gsz = (nM - fm) < WGM ? (nM - fm) : WGM;
        u.pm = fm + ((wgid % nig) % gsz); u.pn = (wgid % nig) / gsz; return true;
    }
    __device__ __forceinline__ void a_ready(const Unit&) const {}
    __device__ __forceinline__ void done(const Unit&) const {}
};

__device__ __forceinline__ unsigned cvt_pk_bf16(float lo, float hi) { unsigned r; asm volatile("v_cvt_pk_bf16_f32 %0, %1, %2" : "=v"(r) : "v"(lo), "v"(hi)); return r; }
template <class Epi, class Sched, bool ALIGN_EPI = false, bool SP2 = false>
__device__ __forceinline__ void gemm_phase(PG8_LAS unsigned char* lds, const Gemm g, const Sched& S, const Epi& E) {
    int tid_ = threadIdx.x; asm volatile("" : "+v"(tid_));
    const int tid = tid_, wid = __builtin_amdgcn_readfirstlane(tid >> 6), lane = tid & 63, wr = wid >> 2, wc = wid & 3, fr = lane & 15, fq = lane >> 4;
    const int K = g.K, nt = K / BK;
    unsigned voffA[2], voffB[2];
#pragma unroll
    for (int i = 0; i < 2; ++i) { int R, C; stage_rc(tid * 16 + i * 8192, R, C); const int Rb = Epi::PERM ? ((R & ~31) + perm32(R & 31)) : R;
        voffA[i] = (unsigned)(R * K + C) * 2u; voffB[i] = (unsigned)(Rb * K + C) * 2u; }
    const size_t kstep = (size_t)(BK * 2);
    const size_t hstep = (size_t)HALF * K * 2;
    const size_t tstep = 2 * hstep;
    const unsigned ldsw = (unsigned)wid * 1024u;
    const int aoff = lds_byte(wr * 64 + fr, fq * 8), boff = lds_byte(wc * 32 + fr, fq * 8);
#define PG8_SA(b, h) (((b) * 2 + (h)) * HTB)
#define PG8_SB(b, h) ((4 + (b) * 2 + (h)) * HTB)
#define PG8_STAGE(bufoff, gbase, voff) do { _Pragma("unroll") for (int _i = 0; _i < 2; ++_i) \
        __builtin_amdgcn_global_load_lds((const unsigned*)((const char*)(gbase) + (voff)[_i]), (PG8_LAS unsigned*)(lds + (bufoff) + ldsw + _i * 8192), 16, 0, 0); } while (0)
#define PG8_LDA(dst, b, h) do { _Pragma("unroll") for (int m = 0; m < 4; ++m) _Pragma("unroll") for (int k = 0; k < 2; ++k) dst[m][k] = *(const PG8_LAS bf16x8*)(lds + PG8_SA(b, h) + aoff + m * 2048 + k * 1024); } while (0)
#define PG8_LDB(dst, b, h) do { _Pragma("unroll") for (int n = 0; n < 2; ++n) _Pragma("unroll") for (int k = 0; k < 2; ++k) dst[n][k] = *(const PG8_LAS bf16x8*)(lds + PG8_SB(b, h) + boff + n * 2048 + k * 1024); } while (0)
#define PG8_MMA(ai, bj, At, Bt) do { __builtin_amdgcn_s_setprio(1); _Pragma("unroll") for (int m = 0; m < 4; ++m) _Pragma("unroll") for (int n = 0; n < 2; ++n) _Pragma("unroll") for (int k = 0; k < 2; ++k) \
        acc[ai][bj][m][n] = __builtin_amdgcn_mfma_f32_16x16x32_bf16(Bt[n][k], At[m][k], acc[ai][bj][m][n], 0, 0, 0); __builtin_amdgcn_s_setprio(0); } while (0)
#define PG8_WAIT_V(n) asm volatile("s_waitcnt vmcnt(" #n ")" ::: "memory")
#define PG8_WAIT_L(n) asm volatile("s_waitcnt lgkmcnt(" #n ")" ::: "memory")
#define PG8_BAR __builtin_amdgcn_s_barrier()
#define PG8_SCHED __builtin_amdgcn_sched_barrier(0)
    Unit cur, nxt; int ui = 0;
    if (!S.next(0, cur)) return;
    f32x4 acc[2][2][4][2];
#pragma unroll
    for (int a = 0; a < 2; ++a)
#pragma unroll
        for (int b = 0; b < 2; ++b)
#pragma unroll
            for (int m = 0; m < 4; ++m)
#pragma unroll
                for (int n = 0; n < 2; ++n) acc[a][b][m][n] = (f32x4){0.f, 0.f, 0.f, 0.f};
    bf16x8 At[4][2], B0[2][2], B1[2][2];
    const char* cA = (const char*)g.A + (size_t)cur.pm * tstep; const char* cB = (const char*)g.Bt + (size_t)cur.pn * tstep;
    S.a_ready(cur);
    if constexpr (SP2) {
        PG8_STAGE(PG8_SB(0, 0), cB, voffB); PG8_STAGE(PG8_SB(0, 1), cB + hstep, voffB); PG8_STAGE(PG8_SA(0, 0), cA, voffA); PG8_STAGE(PG8_SA(0, 1), cA + hstep, voffA);
        if (wr == 1) PG8_BAR;
        PG8_WAIT_V(2); PG8_BAR;
        PG8_STAGE(PG8_SB(1, 0), cB + kstep, voffB); PG8_STAGE(PG8_SA(1, 0), cA + kstep, voffA); PG8_STAGE(PG8_SB(1, 1), cB + hstep + kstep, voffB);
        PG8_WAIT_V(6); PG8_BAR;
    } else {
        PG8_STAGE(PG8_SB(0, 0), cB, voffB); PG8_STAGE(PG8_SA(0, 0), cA, voffA); PG8_STAGE(PG8_SB(0, 1), cB + hstep, voffB); PG8_STAGE(PG8_SA(0, 1), cA + hstep, voffA);
        if (wr == 1) PG8_BAR;
        PG8_WAIT_V(4); PG8_BAR;
        PG8_STAGE(PG8_SB(1, 0), cB + kstep, voffB); PG8_STAGE(PG8_SA(1, 0), cA + kstep, voffA); PG8_STAGE(PG8_SB(1, 1), cB + hstep + kstep, voffB);
        PG8_WAIT_V(6); PG8_BAR;
    }
    for (;;) {
        const bool has_next = S.next(ui + 1, nxt);
        const char* nA = has_next ? (const char*)g.A + (size_t)nxt.pm * tstep : cA; const char* nB = has_next ? (const char*)g.Bt + (size_t)nxt.pn * tstep : cB;
        for (int t = 0; t < nt; t += 2) {
            const bool last = (t == nt - 2);
            const char* a1 = cA + (size_t)(t + 1) * kstep;
            const char* a2 = last ? nA : cA + (size_t)(t + 2) * kstep; const char* b2 = last ? nB : cB + (size_t)(t + 2) * kstep;
            const char* a3 = a2 + kstep; const char* b3 = b2 + kstep;
            if (last && has_next) S.a_ready(nxt);
            if constexpr (SP2) {
            PG8_LDB(B0, 0, 0); PG8_LDB(B1, 0, 1); PG8_SCHED; PG8_LDA(At, 0, 0); PG8_STAGE(PG8_SA(1, 1), a1 + hstep, voffA);
            PG8_WAIT_V(8); PG8_WAIT_L(0); PG8_BAR; PG8_MMA(0, 0, At, B0); PG8_MMA(0, 1, At, B1); PG8_BAR; PG8_SCHED;
            PG8_LDA(At, 0, 1); PG8_STAGE(PG8_SB(0, 0), b2, voffB); PG8_STAGE(PG8_SB(0, 1), b2 + hstep, voffB); PG8_STAGE(PG8_SA(0, 0), a2, voffA);
            PG8_WAIT_V(8); PG8_WAIT_L(0); PG8_BAR; PG8_MMA(1, 0, At, B0); PG8_MMA(1, 1, At, B1); PG8_BAR; PG8_SCHED;
            PG8_LDB(B0, 1, 0); PG8_LDB(B1, 1, 1); PG8_SCHED; PG8_LDA(At, 1, 0); PG8_STAGE(PG8_SA(0, 1), a2 + hstep, voffA);
            PG8_WAIT_V(8); PG8_WAIT_L(0); PG8_BAR; PG8_MMA(0, 0, At, B0); PG8_MMA(0, 1, At, B1); PG8_BAR; PG8_SCHED;
            PG8_LDA(At, 1, 1); PG8_STAGE(PG8_SB(1, 0), b3, voffB); PG8_STAGE(PG8_SB(1, 1), b3 + hstep, voffB); PG8_STAGE(PG8_SA(1, 0), a3, voffA);
            PG8_WAIT_V(8); PG8_WAIT_L(0); PG8_BAR; PG8_MMA(1, 0, At, B0); PG8_MMA(1, 1, At, B1); PG8_BAR; PG8_SCHED;
            } else {
            PG8_LDB(B0, 0, 0); PG8_SCHED; PG8_LDA(At, 0, 0); PG8_STAGE(PG8_SA(1, 1), a1 + hstep, voffA);
            PG8_WAIT_L(8); PG8_BAR; PG8_WAIT_L(0); PG8_MMA(0, 0, At, B0); PG8_BAR; PG8_SCHED;
            PG8_LDB(B1, 0, 1); PG8_STAGE(PG8_SB(0, 0), b2, voffB);
            PG8_BAR; PG8_WAIT_L(0); PG8_MMA(0, 1, At, B1); PG8_BAR;
            PG8_LDA(At, 0, 1); PG8_STAGE(PG8_SA(0, 0), a2, voffA);
            PG8_BAR; PG8_WAIT_L(0); PG8_MMA(1, 0, At, B0); PG8_BAR; PG8_SCHED;
            PG8_STAGE(PG8_SB(0, 1), b2 + hstep, voffB);
            PG8_WAIT_V(6); PG8_BAR; PG8_MMA(1, 1, At, B1); PG8_BAR;
            PG8_LDB(B0, 1, 0); PG8_SCHED; PG8_LDA(At, 1, 0); PG8_STAGE(PG8_SA(0, 1), a2 + hstep, voffA);
            PG8_WAIT_L(8); PG8_BAR; PG8_WAIT_L(0); PG8_MMA(0, 0, At, B0); PG8_BAR; PG8_SCHED;
            PG8_LDB(B1, 1, 1); PG8_STAGE(PG8_SB(1, 0), b3, voffB);
            PG8_BAR; PG8_WAIT_L(0); PG8_MMA(0, 1, At, B1); PG8_BAR;
            PG8_LDA(At, 1, 1); PG8_STAGE(PG8_SA(1, 0), a3, voffA);
            PG8_BAR; PG8_WAIT_L(0); PG8_MMA(1, 0, At, B0); PG8_BAR; PG8_SCHED;
            PG8_STAGE(PG8_SB(1, 1), b3 + hstep, voffB);
            PG8_WAIT_V(6); PG8_BAR; PG8_MMA(1, 1, At, B1); PG8_BAR;
            }
        }
        if constexpr (ALIGN_EPI) { if (wr == 0) PG8_BAR; }
        if constexpr (!Epi::AFTER_DRAIN) { E(acc, cur, wr, wc, fr, fq); S.done(cur); }
        if (!has_next) break;
#pragma unroll
        for (int a = 0; a < 2; ++a)
#pragma unroll
            for (int b = 0; b < 2; ++b)
#pragma unroll
                for (int m = 0; m < 4; ++m)
#pragma unroll
                    for (int n = 0; n < 2; ++n) acc[a][b][m][n] = (f32x4){0.f, 0.f, 0.f, 0.f};
        cur = nxt; cA = nA; cB = nB; ++ui;
        if constexpr (ALIGN_EPI) { if (wr == 1) PG8_BAR; }
    }
    PG8_WAIT_V(0);
    if constexpr (!ALIGN_EPI) { if (wr == 0) PG8_BAR; }
    PG8_BAR;
    if constexpr (Epi::AFTER_DRAIN) { E.fused(acc, cur, wr, wc, fr, fq, lds, wid, lane); S.done(cur); }
#undef PG8_SA
#undef PG8_SB
#undef PG8_STAGE
#undef PG8_LDA
#undef PG8_LDB
#undef PG8_MMA
#undef PG8_WAIT_V
#undef PG8_WAIT_L
#undef PG8_BAR
#undef PG8_SCHED
}
}
#ifndef ALIGN1
#define ALIGN1 true
#endif
#ifndef REP_SC
#define REP_SC 1
#endif
#ifndef REP_SE
#define REP_SE 1
#endif
#ifndef REP_SCAN
#define REP_SCAN 1
#endif
#ifndef REP_MIX
#define REP_MIX 1
#endif
#ifndef REP_SA
#define REP_SA 1
#endif
#ifndef REP_SD
#define REP_SD 1
#endif
#ifndef REP_AB
#define REP_AB 1
#endif
#ifndef REP_P1
#define REP_P1 1
#endif
#ifndef REP_P2
#define REP_P2 1
#endif
#ifndef REP_P3
#define REP_P3 1
#endif
#ifndef REP_P4
#define REP_P4 1
#endif
#ifndef REP_P5
#define REP_P5 1
#endif
#ifndef REP_P7
#define REP_P7 1
#endif
#ifndef REP_P8
#define REP_P8 1
#endif
#ifndef REP_SYNC
#define REP_SYNC 1
#endif

namespace pg8 {
__device__ __forceinline__ float silu_f(float x) { return x * __builtin_amdgcn_rcpf(1.f + __builtin_amdgcn_exp2f(-1.4426950408889634f * x)); }
__device__ __forceinline__ float sigmoid_f(float x) { return __builtin_amdgcn_rcpf(1.f + __builtin_amdgcn_exp2f(-1.4426950408889634f * x)); }
__device__ __forceinline__ u32x4 pack8(const f32x4 a, const f32x4 b) { u32x4 w; w.x = cvt_pk_bf16(a[0], a[1]); w.y = cvt_pk_bf16(a[2], a[3]); w.z = cvt_pk_bf16(b[0], b[1]); w.w = cvt_pk_bf16(b[2], b[3]); return w; }

struct EpiBf16S {
    static constexpr bool PERM = true, AFTER_DRAIN = false;
    bf16_t* O; bf16_t* O2; int ldc; int split;
    __device__ __forceinline__ void operator()(const f32x4 (&acc)[2][2][4][2], const Unit& u, int wr, int wc, int fr, int fq) const {
        const int row0 = u.pm * BM + wr * 64 + fr; int colt = u.pn * BM; bf16_t* base = O;
        if (colt >= split) { base = O2; colt -= split; }
        const int col0 = colt + wc * 32 + 8 * fq;
#pragma unroll
        for (int ai = 0; ai < 2; ++ai)
#pragma unroll
            for (int m = 0; m < 4; ++m) { bf16_t* rowp = base + (size_t)(row0 + ai * HALF + m * 16) * ldc + col0;
#pragma unroll
                for (int bj = 0; bj < 2; ++bj) *(u32x4*)(rowp + bj * HALF) = pack8(acc[ai][bj][m][0], acc[ai][bj][m][1]); }
    }
};
struct EpiSwiglu {
    static constexpr bool PERM = true, AFTER_DRAIN = false;
    bf16_t* O; int ldc;
    __device__ __forceinline__ void operator()(const f32x4 (&acc)[2][2][4][2], const Unit& u, int wr, int wc, int fr, int fq) const {
        const int row0 = u.pm * BM + wr * 64 + fr; const int col0 = u.pn * HALF + wc * 32 + 8 * fq;
#pragma unroll
        for (int ai = 0; ai < 2; ++ai)
#pragma unroll
            for (int m = 0; m < 4; ++m) {
                f32x4 v0, v1;
#pragma unroll
                for (int j = 0; j < 4; ++j) { v0[j] = silu_f(acc[ai][0][m][0][j]) * acc[ai][1][m][0][j]; v1[j] = silu_f(acc[ai][0][m][1][j]) * acc[ai][1][m][1][j]; }
                *(u32x4*)(O + (size_t)(row0 + ai * HALF + m * 16) * ldc + col0) = pack8(v0, v1); }
    }
};
struct EpiRes {
    static constexpr bool PERM = true, AFTER_DRAIN = false;
    const float* base; float* out; bf16_t* outb;
    __device__ __forceinline__ void operator()(const f32x4 (&acc)[2][2][4][2], const Unit& u, int wr, int wc, int fr, int fq) const {
        const int row0 = u.pm * BM + wr * 64 + fr; const int col0 = u.pn * BM + wc * 32 + 8 * fq;
#pragma unroll
        for (int ai = 0; ai < 2; ++ai) {
            f32x4 rb[4][2][2];
#pragma unroll
            for (int m = 0; m < 4; ++m) { const size_t off = (size_t)(row0 + ai * HALF + m * 16) * 1024 + col0;
#pragma unroll
                for (int bj = 0; bj < 2; ++bj) { rb[m][bj][0] = __builtin_nontemporal_load((const f32x4*)(base + off + bj * HALF)); rb[m][bj][1] = __builtin_nontemporal_load((const f32x4*)(base + off + bj * HALF + 4)); } }
            __builtin_amdgcn_sched_barrier(0);
#pragma unroll
            for (int m = 0; m < 4; ++m) { const size_t off = (size_t)(row0 + ai * HALF + m * 16) * 1024 + col0;
#pragma unroll
                for (int bj = 0; bj < 2; ++bj) {
                    const f32x4 v0 = rb[m][bj][0] + acc[ai][bj][m][0], v1 = rb[m][bj][1] + acc[ai][bj][m][1];
                    if (out) { __builtin_nontemporal_store(v0, (f32x4*)(out + off + bj * HALF)); __builtin_nontemporal_store(v1, (f32x4*)(out + off + bj * HALF + 4)); }
                    if (outb) *(u32x4*)(outb + off + bj * HALF) = pack8(v0, v1); } }
            __builtin_amdgcn_sched_barrier(0);
        }
    }
};
struct EpiPle {
    static constexpr bool PERM = true, AFTER_DRAIN = false;
    float* x; const bf16_t* pp;
    __device__ __forceinline__ void operator()(const f32x4 (&acc)[2][2][4][2], const Unit& u, int wr, int wc, int fr, int fq) const {
        const int row0 = u.pm * BM + wr * 64 + fr; const int col0 = u.pn * BM + wc * 32 + 8 * fq;
#pragma unroll
        for (int ai = 0; ai < 2; ++ai)
#pragma unroll
            for (int mp = 0; mp < 2; ++mp) {
                f32x4 rb[2][2][2]; u32x4 rp[2][2];
#pragma unroll
                for (int mm = 0; mm < 2; ++mm) { const size_t off = (size_t)(row0 + ai * HALF + (2 * mp + mm) * 16) * 1024 + col0;
#pragma unroll
                    for (int bj = 0; bj < 2; ++bj) { rb[mm][bj][0] = *(const f32x4*)(x + off + bj * HALF); rb[mm][bj][1] = *(const f32x4*)(x + off + bj * HALF + 4); rp[mm][bj] = *(const u32x4*)(pp + off + bj * HALF); } }
                __builtin_amdgcn_sched_barrier(0);
#pragma unroll
                for (int mm = 0; mm < 2; ++mm) { const int m = 2 * mp + mm; const size_t off = (size_t)(row0 + ai * HALF + m * 16) * 1024 + col0;
#pragma unroll
                    for (int bj = 0; bj < 2; ++bj) {
                        const f32x4 b0 = rb[mm][bj][0], b1 = rb[mm][bj][1]; const u32x4 pw = rp[mm][bj];
                        f32x4 p0, p1;
                        p0[0] = __uint_as_float(pw.x << 16); p0[1] = __uint_as_float(pw.x & 0xffff0000u); p0[2] = __uint_as_float(pw.y << 16); p0[3] = __uint_as_float(pw.y & 0xffff0000u);
                        p1[0] = __uint_as_float(pw.z << 16); p1[1] = __uint_as_float(pw.z & 0xffff0000u); p1[2] = __uint_as_float(pw.w << 16); p1[3] = __uint_as_float(pw.w & 0xffff0000u);
                        f32x4 v0, v1;
#pragma unroll
                        for (int j = 0; j < 4; ++j) { v0[j] = b0[j] + sigmoid_f(acc[ai][bj][m][0][j]) * p0[j]; v1[j] = b1[j] + sigmoid_f(acc[ai][bj][m][1][j]) * p1[j]; }
                        *(f32x4*)(x + off + bj * HALF) = v0; *(f32x4*)(x + off + bj * HALF + 4) = v1; } }
                __builtin_amdgcn_sched_barrier(0);
            }
    }
};

template <int MODE> struct EpiNorm {
    static constexpr bool PERM = true, AFTER_DRAIN = true;
    const float* base; float* out; const bf16_t* pp; bf16_t* nb; const float* g; unsigned* xbuf; unsigned* cnt; const bf16_t* b16;
    __device__ __forceinline__ void operator()(const f32x4 (&)[2][2][4][2], const Unit&, int, int, int, int) const {}
    __device__ __forceinline__ void fused(f32x4 (&acc)[2][2][4][2], const Unit& u, int wr, int wc, int fr, int fq, PG8_LAS unsigned char* lds, int wid, int lane) const {
        PG8_LAS float* Pp = (PG8_LAS float*)lds;
        PG8_LAS float* Ss = (PG8_LAS float*)(lds + 8192);
        const int row0 = u.pm * BM + wr * 64 + fr; const int col0 = u.pn * BM + wc * 32 + 8 * fq;
#pragma unroll
        for (int ai = 0; ai < 2; ++ai)
#pragma unroll
            for (int m = 0; m < 4; ++m) { const size_t off = (size_t)(row0 + ai * HALF + m * 16) * 1024 + col0; float sq = 0.f;
#pragma unroll
                for (int bj = 0; bj < 2; ++bj) {
                    f32x4 b0, b1;
                    if (MODE == 0) { b0 = __builtin_nontemporal_load((const f32x4*)(base + off + bj * HALF)); b1 = __builtin_nontemporal_load((const f32x4*)(base + off + bj * HALF + 4)); }
                    else { const u32x4 xw = *(const u32x4*)(b16 + off + bj * HALF);
                        b0[0] = __uint_as_float(xw.x << 16); b0[1] = __uint_as_float(xw.x & 0xffff0000u); b0[2] = __uint_as_float(xw.y << 16); b0[3] = __uint_as_float(xw.y & 0xffff0000u);
                        b1[0] = __uint_as_float(xw.z << 16); b1[1] = __uint_as_float(xw.z & 0xffff0000u); b1[2] = __uint_as_float(xw.w << 16); b1[3] = __uint_as_float(xw.w & 0xffff0000u); }
                    f32x4 v0, v1;
                    if (MODE == 0) { v0 = b0 + acc[ai][bj][m][0]; v1 = b1 + acc[ai][bj][m][1]; }
                    else { const u32x4 pw = *(const u32x4*)(pp + off + bj * HALF); f32x4 p0, p1;
                        p0[0] = __uint_as_float(pw.x << 16); p0[1] = __uint_as_float(pw.x & 0xffff0000u); p0[2] = __uint_as_float(pw.y << 16); p0[3] = __uint_as_float(pw.y & 0xffff0000u);
                        p1[0] = __uint_as_float(pw.z << 16); p1[1] = __uint_as_float(pw.z & 0xffff0000u); p1[2] = __uint_as_float(pw.w << 16); p1[3] = __uint_as_float(pw.w & 0xffff0000u);
#pragma unroll
                        for (int j = 0; j < 4; ++j) { v0[j] = b0[j] + sigmoid_f(acc[ai][bj][m][0][j]) * p0[j]; v1[j] = b1[j] + sigmoid_f(acc[ai][bj][m][1][j]) * p1[j]; } }
                    if (MODE != 2) { __builtin_nontemporal_store(v0, (f32x4*)(out + off + bj * HALF)); __builtin_nontemporal_store(v1, (f32x4*)(out + off + bj * HALF + 4)); }
                    acc[ai][bj][m][0] = v0; acc[ai][bj][m][1] = v1;
                    sq += (v0[0] * v0[0] + v0[1] * v0[1]) + (v0[2] * v0[2] + v0[3] * v0[3]) + (v1[0] * v1[0] + v1[1] * v1[1]) + (v1[2] * v1[2] + v1[3] * v1[3]); }
                sq += __shfl_xor(sq, 16); sq += __shfl_xor(sq, 32);
                if (fq == 0) Pp[(ai * HALF + wr * 64 + m * 16 + fr) * 4 + wc] = sq; }
        asm volatile("s_waitcnt lgkmcnt(0)" ::: "memory"); __builtin_amdgcn_s_barrier(); asm volatile("" ::: "memory");
        const int row = wid * 32 + (lane & 31);
        if (lane < 32) { const float s = (Pp[row * 4 + 0] + Pp[row * 4 + 1]) + (Pp[row * 4 + 2] + Pp[row * 4 + 3]);
            __hip_atomic_store(xbuf + ((size_t)(u.pm * BM + row) * 4 + u.pn), __float_as_uint(s), __ATOMIC_RELAXED, __HIP_MEMORY_SCOPE_AGENT); }
        asm volatile("s_waitcnt vmcnt(0)" ::: "memory");
        if (lane == 0) __hip_atomic_fetch_add(cnt + 64 * u.pm, 1u, __ATOMIC_RELAXED, __HIP_MEMORY_SCOPE_AGENT);
        if (wid == 0) { unsigned spins = 0;
            while ((unsigned)__builtin_amdgcn_readfirstlane(__hip_atomic_load(cnt + 64 * u.pm, __ATOMIC_RELAXED, __HIP_MEMORY_SCOPE_AGENT)) < 32u && ++spins < (1u << 22)) __builtin_amdgcn_s_sleep(2);
            __builtin_amdgcn_fence(__ATOMIC_ACQUIRE, "agent"); }
        asm volatile("s_waitcnt vmcnt(0) lgkmcnt(0)" ::: "memory"); __builtin_amdgcn_s_barrier(); asm volatile("" ::: "memory");
        if (lane < 32) { const unsigned* sl = xbuf + (size_t)(u.pm * BM + row) * 4; float t = 0.f;
#pragma unroll
            for (int k = 0; k < 4; ++k) t += __uint_as_float(__hip_atomic_load(sl + k, __ATOMIC_RELAXED, __HIP_MEMORY_SCOPE_AGENT));
            Ss[row] = rsqrtf(t * (1.f / 1024.f) + 1e-6f); }
        asm volatile("s_waitcnt vmcnt(0) lgkmcnt(0)" ::: "memory"); __builtin_amdgcn_s_barrier(); asm volatile("" ::: "memory");
        f32x4 gv[2][2];
#pragma unroll
        for (int bj = 0; bj < 2; ++bj) { gv[bj][0] = *(const f32x4*)(g + col0 + bj * HALF); gv[bj][1] = *(const f32x4*)(g + col0 + bj * HALF + 4); }
#pragma unroll
        for (int ai = 0; ai < 2; ++ai)
#pragma unroll
            for (int m = 0; m < 4; ++m) { const int rl = ai * HALF + wr * 64 + m * 16 + fr; const float rs = Ss[rl]; const size_t off = (size_t)(u.pm * BM + rl) * 1024 + col0;
#pragma unroll
                for (int bj = 0; bj < 2; ++bj) { const f32x4 o0 = acc[ai][bj][m][0] * rs * gv[bj][0], o1 = acc[ai][bj][m][1] * rs * gv[bj][1];
                    if (MODE == 2) { __builtin_nontemporal_store(o0, (f32x4*)(out + off + bj * HALF)); __builtin_nontemporal_store(o1, (f32x4*)(out + off + bj * HALF + 4)); }
                    else *(u32x4*)(nb + off + bj * HALF) = pack8(o0, o1); } }
    }
};
}

#define LAS __attribute__((address_space(3)))
typedef unsigned short bf16;
typedef float f32x4 __attribute__((ext_vector_type(4)));
typedef float f32x16 __attribute__((ext_vector_type(16)));
typedef short bf16x8 __attribute__((ext_vector_type(8)));
typedef unsigned u32x4 __attribute__((ext_vector_type(4)));
typedef unsigned u32x2 __attribute__((ext_vector_type(2)));
constexpr int NB = 8, SEQ = 2048, DM = 1024, M = NB * SEQ, DEPTH = 2, PLE = 256, DFF = 2816, DIN = 3080, NPROJ = 3072, PHALF = 1536;
constexpr float EPS = 1e-6f;
constexpr int NTHREADS = 512, NWAVES = 8;
constexpr int LDS_BYTES = 145408;
constexpr size_t MiB = 1u << 20;
constexpr size_t WS_SMALL = 1 * MiB;
constexpr size_t WS_W = 2 * MiB;
constexpr size_t WO_IN = 0, WO_AB = 6 * MiB, WO_OUT = WO_AB + 65536, WO_GU = WO_OUT + 2 * MiB, WO_DOWN = WO_GU + 11 * MiB, WO_PG = WO_DOWN + 5632 * 1024, WO_PP = WO_PG + 2 * MiB, WO_END = WO_PP + 512 * 1024;
static_assert(WO_END <= 28 * MiB, "weights region");
constexpr size_t WS_HB = 30 * MiB;
constexpr size_t WS_PA = 62 * MiB;
constexpr size_t WS_PB = 110 * MiB;
constexpr size_t WS_REC = 158 * MiB;
constexpr size_t WS_U = 219 * MiB;
constexpr size_t WS_END = 254 * MiB;
constexpr int REC_BYTES = 62464, RO_NEGW = 0, RO_QE = 17408, RO_KDT = 34816, RO_ATTN = 53248;

__device__ __forceinline__ unsigned f2bf(float f) { unsigned u = __builtin_bit_cast(unsigned, f); return (u + 0x7fffu + ((u >> 16) & 1u)) >> 16; }
__device__ __forceinline__ unsigned pk2(float lo, float hi) { return pg8::cvt_pk_bf16(lo, hi); }
__device__ __forceinline__ float bf_lo(unsigned w) { return __uint_as_float(w << 16); }
__device__ __forceinline__ float bf_hi(unsigned w) { return __uint_as_float(w & 0xffff0000u); }
__device__ __forceinline__ float wave_sum(float v) {
#pragma unroll
    for (int o = 1; o < 64; o <<= 1) v += __shfl_xor(v, o);
    return v;
}
__device__ __forceinline__ int crow(int reg, int h) { return (reg & 3) + 8 * (reg >> 2) + 4 * h; }
__device__ __forceinline__ int swap23(int x) { return (x & ~12) | ((x & 4) << 1) | ((x & 8) >> 1); }
#define MFMA32(a, b, c) __builtin_amdgcn_mfma_f32_32x32x16_bf16((a), (b), (c), 0, 0, 0)
typedef float f32x2_t __attribute__((ext_vector_type(2))); typedef __bf16 bf16x2_t __attribute__((ext_vector_type(2)));
__device__ __forceinline__ unsigned cvtpk_c(float lo, float hi) { f32x2_t v = {lo, hi}; bf16x2_t b = __builtin_convertvector(v, bf16x2_t); return __builtin_bit_cast(unsigned, b); }
__device__ __forceinline__ bf16x8 pack_step(const f32x16& x, int s) {
    u32x4 p; p.x = cvtpk_c(x[8 * s], x[8 * s + 1]); p.y = cvtpk_c(x[8 * s + 2], x[8 * s + 3]); p.z = cvtpk_c(x[8 * s + 4], x[8 * s + 5]); p.w = cvtpk_c(x[8 * s + 6], x[8 * s + 7]);
    return __builtin_bit_cast(bf16x8, p);
}

__device__ __forceinline__ void transpose_item(const float* W, int ldw, int k0, int srcc0, bf16* WT, int ldt, int dstr0, LAS float* scr, int lane) {
    float wv_[32];
#pragma unroll
    for (int i = 0; i < 32; ++i) { const int kk = 2 * i + (lane >> 5); wv_[i] = W[(size_t)(k0 + kk) * ldw + srcc0 + (lane & 31)]; }
#pragma unroll
    for (int i = 0; i < 32; ++i) { const int kk = 2 * i + (lane >> 5); scr[kk * 33 + (lane & 31)] = wv_[i]; }
    asm volatile("s_waitcnt lgkmcnt(0)" ::: "memory");
    const int c = lane & 7;
#pragma unroll
    for (int j = 0; j < 4; ++j) { const int n = (lane >> 3) + 8 * j; const LAS float* s = scr + (8 * c) * 33 + n;
        u32x4 o; o.x = pk2(s[0 * 33], s[1 * 33]); o.y = pk2(s[2 * 33], s[3 * 33]); o.z = pk2(s[4 * 33], s[5 * 33]); o.w = pk2(s[6 * 33], s[7 * 33]);
        *(u32x4*)(WT + (size_t)(dstr0 + n) * ldt + k0 + 8 * c) = o; }
    asm volatile("s_waitcnt lgkmcnt(0)" ::: "memory");
}

#define XB_TMO      128
#define XB_XCNT(j)  (256  + 64 * (j))
#define XB_XSUB(j)  (1280 + 64 * (j))
#define XB_XGEN(j)  (2304 + 64 * (j))
#define XB_TOP      3328
#define XB_TOPGEN   3392
#define XCD_BAR_WORDS 3456
#define XB_SPIN_CAP (1u << 18)

__device__ __forceinline__ unsigned xb_ld(unsigned* p)              { return __hip_atomic_load(p, __ATOMIC_RELAXED, __HIP_MEMORY_SCOPE_AGENT); }
__device__ __forceinline__ unsigned xb_add(unsigned* p, unsigned v) { return __hip_atomic_fetch_add(p, v, __ATOMIC_RELAXED, __HIP_MEMORY_SCOPE_AGENT); }
__device__ __forceinline__ unsigned xb_xcc_id() { return (unsigned)__builtin_amdgcn_s_getreg((3 << 11) | 20) & 0xFu; }
#define XB_SPIN(cond, bar) do { unsigned _sp = 0; while (cond) { __builtin_amdgcn_s_sleep(1); \
    if ((++_sp & 255u) == 0u) { if (xb_ld(&(bar)[XB_TMO])) break; if (_sp > XB_SPIN_CAP) { atomicAdd(&(bar)[XB_TMO], 1u); break; } } } } while (0)

struct XcdBarrier {
    unsigned* bar; unsigned x;
    volatile LAS unsigned* st;
};

__device__ __forceinline__ XcdBarrier xcd_barrier_post(unsigned* bar, volatile LAS unsigned* st) {
    XcdBarrier b; b.bar = bar; b.x = xb_xcc_id(); b.st = st;
    if (threadIdx.x == 0) (void)xb_add(&bar[XB_XCNT(b.x)], 1u);
    return b;
}
__device__ __forceinline__ void xcd_barrier_complete(unsigned* bar, unsigned x, unsigned& nloc, unsigned& nx) {
    const unsigned G = gridDim.x * gridDim.y * gridDim.z;
    unsigned sum, cnt, mine, sp = 0u;
    for (;;) {
        sum = 0u; cnt = 0u; mine = 0u;
#pragma unroll
        for (unsigned j = 0; j < 16; ++j) { const unsigned c = xb_ld(&bar[XB_XCNT(j)]); sum += c; cnt += (c > 0u) ? 1u : 0u; mine = (j == x) ? c : mine; }
        if (sum == G) break;
        __builtin_amdgcn_s_sleep(1);
        if ((++sp & 255u) == 0u) { if (xb_ld(&bar[XB_TMO])) break; if (sp > XB_SPIN_CAP) { atomicAdd(&bar[XB_TMO], 1u); break; } }
    }
    nloc = mine > 0u ? mine : 1u; nx = cnt > 0u ? cnt : 1u;
}

__device__ __forceinline__ void xcd_barrier(const XcdBarrier& b) {
    asm volatile("s_waitcnt vmcnt(0)" ::: "memory");
    __syncthreads();
    if (threadIdx.x == 0) {
        unsigned* bar = b.bar;
        __builtin_amdgcn_s_waitcnt(0);
        unsigned nloc = b.st[0], nx = b.st[1];
        if (nloc == 0u) { xcd_barrier_complete(bar, b.x, nloc, nx); b.st[0] = nloc; b.st[1] = nx; }
        const unsigned old = xb_add(&bar[XB_XSUB(b.x)], 1u);
        const unsigned gen = old / nloc;
        if (old + 1u == (gen + 1u) * nloc) {
            __builtin_amdgcn_fence(__ATOMIC_RELEASE, "agent");
            asm volatile("s_waitcnt vmcnt(0)" ::: "memory");
            const unsigned og = xb_add(&bar[XB_TOP], 1u);
            const unsigned tg = og / nx;
            if (og + 1u == (tg + 1u) * nx) xb_add(&bar[XB_TOPGEN], 1u);
            else XB_SPIN(xb_ld(&bar[XB_TOPGEN]) == tg, bar);
            __builtin_amdgcn_fence(__ATOMIC_ACQUIRE, "agent");
            xb_add(&bar[XB_XGEN(b.x)], 1u);
            asm volatile("s_waitcnt vmcnt(0)" ::: "memory");
        } else {
            XB_SPIN(xb_ld(&bar[XB_XGEN(b.x)]) == gen, bar);
            __builtin_amdgcn_fence(__ATOMIC_ACQUIRE, "agent");
            asm volatile("s_waitcnt vmcnt(0)" ::: "memory");
        }
    }
    __syncthreads();
}

#define WG_BAR() do { asm volatile("s_waitcnt lgkmcnt(0)" ::: "memory"); __builtin_amdgcn_s_barrier(); asm volatile("" ::: "memory"); } while (0)
struct Params { const float* in[19]; float* out; unsigned char* ws; };

__global__ void __launch_bounds__(NTHREADS, 2) fwd_kernel(Params P) {
    extern __shared__ __attribute__((aligned(16))) unsigned char lds_raw[];
    LAS unsigned char* lds = (LAS unsigned char*)lds_raw;
    cg::grid_group grid = cg::this_grid();
    volatile LAS unsigned* xb_st = (volatile LAS unsigned*)(lds + 145152);
    if (threadIdx.x < 2) xb_st[threadIdx.x] = 0u;
    __syncthreads();
    XcdBarrier xbar = xcd_barrier_post((unsigned*)P.ws, xb_st);
    if (P.ws == nullptr) grid.sync();
#define PH_BEGIN \
    int tid = threadIdx.x; asm volatile("" : "+v"(tid)); \
    const int lane = tid & 63, wave = __builtin_amdgcn_readfirstlane(tid >> 6); \
    int G = gridDim.x, bid = blockIdx.x; asm volatile("" : "+s"(G), "+s"(bid)); \
    const int gw = bid * NWAVES + wave, NGW = G * NWAVES, gt = bid * NTHREADS + tid, NGT = G * NTHREADS; \
    const int r32 = lane & 31, hh = lane >> 5; \
    int Lq = L; asm volatile("" : "+s"(Lq)); \
    __attribute__((address_space(1))) unsigned char* wsg_ = (__attribute__((address_space(1))) unsigned char*)P.ws; asm volatile("" : "+s"(wsg_)); \
    unsigned char* ws = (unsigned char*)wsg_;     \
    (void)gw; (void)NGW; (void)gt; (void)NGT; (void)r32; (void)hh; (void)lane; (void)wave; (void)G; (void)bid; (void)Lq; (void)ws;
#define XRES (P.out)
#define HB ((bf16*)(ws + WS_HB))
#define PA ((bf16*)(ws + WS_PA))
#define PB ((bf16*)(ws + WS_PB))
#define FF ((bf16*)(ws + WS_PA))
#define OB ((float*)(ws + WS_PA))
#define REC (ws + WS_REC)
#define PBF ((bf16*)(ws + WS_REC))
#define UB ((float*)(ws + WS_U))
#define PP ((bf16*)(ws + WS_U))
#define GL ((float*)(ws + WS_SMALL))
#define XB ((bf16*)(ws + WS_REC + 16 * MiB))
#define XCH(bank) ((unsigned*)(ws + 253 * MiB + (size_t)(bank) * 262144))
#define XCNT(bank) ((unsigned*)(ws + 65536 + (size_t)(bank) * 16384))
#define GARR ((float*)(ws + WS_SMALL + 262144))
#define BARR ((float*)(ws + WS_SMALL + 524288))
#define Win_t ((bf16*)(ws + WS_W + WO_IN))
#define Wab_t ((bf16*)(ws + WS_W + WO_AB))
#define Wout_t ((bf16*)(ws + WS_W + WO_OUT))
#define Wgu_t ((bf16*)(ws + WS_W + WO_GU))
#define Wdown_t ((bf16*)(ws + WS_W + WO_DOWN))
#define Wpg_t ((bf16*)(ws + WS_W + WO_PG))
#define Wpp_t ((bf16*)(ws + WS_W + WO_PP))

    for (int L = 0; L < DEPTH; ++L) {
#ifndef SKIP_P1
        if (L == 0)
        for (int rep_ = 0; rep_ < REP_P1; ++rep_)
        {
        {
            PH_BEGIN
            const float* xin = (Lq == 0) ? P.in[0] : XRES;
            const float* norm1_g = P.in[2] + Lq * DM; const float* w_in = P.in[3] + (size_t)Lq * DM * DIN;
            const float* w_out = P.in[11] + (size_t)Lq * DM * DM;
            const float* w_gate = P.in[13] + (size_t)Lq * DM * DFF; const float* w_up = P.in[14] + (size_t)Lq * DM * DFF; const float* w_down = P.in[15] + (size_t)Lq * DFF * DM;
            const float* ple_proj = P.in[16] + (size_t)Lq * PLE * DM; const float* ple_gate = P.in[17] + (size_t)Lq * DM * DM;
            LAS float* scr = (LAS float*)(lds + wave * 8448);
            for (int it = gw; it < 16 * 96; it += NGW) { const int kb = it / 96, nb = it % 96; const int d0 = 32 * nb; transpose_item(w_in, DIN, 64 * kb, d0 < 2048 ? d0 : d0 + 8, Win_t, DM, d0, scr, lane); }
            for (int i = gt; i < 8 * DM; i += NGT) { const int n = i >> 10, k = i & 1023; Wab_t[n * DM + k] = (bf16)f2bf(w_in[(size_t)k * DIN + 2048 + n]); }
            if (Lq == 0)
            for (int m = gw; m < M; m += NGW) {
                const f32x4* xr = (const f32x4*)(xin + (size_t)m * DM) + lane; f32x4 v[4]; float s = 0.f;
#pragma unroll
                for (int j = 0; j < 4; ++j) { v[j] = xr[64 * j]; s += (v[j].x * v[j].x + v[j].y * v[j].y) + (v[j].z * v[j].z + v[j].w * v[j].w); }
                const float rstd = rsqrtf(wave_sum(s) * (1.f / DM) + EPS);
                u32x2* o8 = (u32x2*)(XB + (size_t)m * DM) + lane;
#pragma unroll
                for (int j = 0; j < 4; ++j) { const f32x4 gv = ((const f32x4*)norm1_g)[lane + 64 * j]; u32x2 w; w.x = pk2(v[j].x * rstd * gv.x, v[j].y * rstd * gv.y); w.y = pk2(v[j].z * rstd * gv.z, v[j].w * rstd * gv.w); o8[64 * j] = w; }
            }
        }
        }
#endif
        if (L == 0) { for (int rs_ = 0; rs_ < REP_SYNC; ++rs_) xcd_barrier(xbar); }

#ifndef SKIP_P2
        for (int rep_ = 0; rep_ < REP_P2; ++rep_)
        {
        {
            PH_BEGIN
            const float* a_log = P.in[5] + Lq * 4; const float* dt_bias = P.in[6] + Lq * 4;
            pg8::Gemm g{XB, Win_t, M, NPROJ, DM}; pg8::StaticOrder S; S.init(M, NPROJ, G, bid);
            pg8::EpiBf16S E{PA, PB, PHALF, PHALF};
            pg8::gemm_phase<pg8::EpiBf16S, pg8::StaticOrder, true, true>(lds, g, S, E);
            for (int unit = bid; unit < M / 64; unit += G) {
                const size_t row0 = (size_t)unit * 64; const int tile = wave & 3, kh = wave >> 2;
                f32x4 acc = {0.f, 0.f, 0.f, 0.f};
                const bf16* arow = XB + (row0 + 16 * tile + (lane & 15)) * DM + 512 * kh + 8 * (lane >> 4);
                const bf16* brow = Wab_t + (size_t)(lane & 7) * DM + 512 * kh + 8 * (lane >> 4);
                bf16x8 af[16], bfr[16];
#pragma unroll
                for (int s = 0; s < 16; ++s) { af[s] = *(const bf16x8*)(arow + 32 * s); bfr[s] = *(const bf16x8*)(brow + 32 * s); }
#pragma unroll
                for (int s = 0; s < 16; ++s) acc = __builtin_amdgcn_mfma_f32_16x16x32_bf16(af[s], bfr[s], acc, 0, 0, 0);
                LAS f32x4* red = (LAS f32x4*)lds;
                if (kh == 1) red[tile * 64 + lane] = acc;
                WG_BAR();
                if (kh == 0) {
                    acc += red[tile * 64 + lane];
                    const int col = lane & 15;
                    if (col < 8) { const int hd = col & 3; const float al = __expf(a_log[hd]), db = dt_bias[hd];
#pragma unroll
                        for (int j = 0; j < 4; ++j) { const size_t row = row0 + 16 * tile + 4 * (lane >> 4) + j; const float v = acc[j];
                            if (col < 4) { const float z = v + db; const float sp = fmaxf(z, 0.f) + log1pf(__expf(-fabsf(z))); GARR[row * 4 + hd] = -al * sp; }
                            else BARR[row * 4 + hd] = pg8::sigmoid_f(v); } }
                }
                WG_BAR();
            }
        }
        }
#endif
        for (int rs_ = 0; rs_ < REP_SYNC; ++rs_) xcd_barrier(xbar);

#ifndef SKIP_P3
        for (int rep_ = 0; rep_ < REP_P3; ++rep_)
        {
        {
            PH_BEGIN
            const float* conv_qkv = P.in[4] + Lq * 4 * 1536;
            LAS bf16* ks = (LAS bf16*)(lds + 0); LAS bf16* qs = (LAS bf16*)(lds + 17408); LAS bf16* kdT = (LAS bf16*)(lds + 34816);
            LAS bf16* vbT = (LAS bf16*)(lds + 53248); LAS bf16* kbeT = (LAS bf16*)(lds + 71680); LAS float* Lf = (LAS float*)(lds + 90112);
            LAS bf16* Ts = (LAS bf16*)(lds + 107520); LAS float* LfT = (LAS float*)(lds + 119808);     LAS float* gS = (LAS float*)(lds + 116736); LAS float* betaS = gS + 256; LAS float* gcS = gS + 512;
            for (int unit = bid; unit < NB * 32; unit += G) {
                const int b = unit >> 5, n = unit & 31, t0 = n * 64; const size_t row0 = (size_t)b * SEQ + t0;
                if (tid < 256) { const int tok = tid >> 2, hd = tid & 3; gS[hd * 64 + tok] = GARR[(row0 + tok) * 4 + hd]; betaS[hd * 64 + tok] = BARR[(row0 + tok) * 4 + hd]; }
                WG_BAR();
                if (wave < 4) { float v = gS[wave * 64 + lane];
#pragma unroll
                    for (int o = 1; o < 64; o <<= 1) { const float t = __shfl_up(v, o); if (lane >= o) v += t; }
                    gcS[wave * 64 + lane] = v; }
                WG_BAR();
                for (int h = 0; h < 4; ++h) {
                    int tidh = tid; asm volatile("" : "+v"(tidh));
                    const int laneh = tidh & 63, r32h = laneh & 31, hhh = laneh >> 5;
                    const int item = (b * 4 + h) * 32 + n;
                    unsigned char* rec = REC + (size_t)item * REC_BYTES;
                    LAS float* cwS = (LAS float*)(lds + 137216);
                    for (int e = tidh; e < 1536; e += NTHREADS) cwS[e] = conv_qkv[((e >> 7) & 3) * 1536 + (e >> 9) * 512 + h * 128 + (e & 127)];
                    WG_BAR();
                    for (int ra_ = 0; ra_ < REP_SA; ++ra_) {
                        const int tk = tidh >> 3, cgp = tidh & 7; const int t = t0 + tk;
                        const float gcv = gcS[h * 64 + tk], btv = betaS[h * 64 + tk], glast = gcS[h * 64 + 63];
                        const float eg = __expf(gcv), egl = __expf(glast - gcv);
                        const int tkp = (tk & ~15) | swap23(tk & 15);
                        const int tkx = (((tk >> 3) ^ cgp) << 3) | (tk & 7), tkpx = (((tkp >> 3) ^ cgp) << 3) | (tkp & 7);
#pragma unroll
                        for (int part = 0; part < 3; ++part) {
                            const int colb = part * 512 + h * 128 + 16 * cgp;
                            float y[16];
#pragma unroll
                            for (int i = 0; i < 16; ++i) y[i] = 0.f;
#pragma unroll
                            for (int j = 0; j < 4; ++j) {
                                const int tt = t - 3 + j;
                                if (tt >= 0) {
                                    const u32x4* src = (const u32x4*)(PA + ((size_t)b * SEQ + tt) * PHALF + colb);
                                    const u32x4 x0 = src[0], x1 = src[1];
                                    const LAS f32x4* wv = (const LAS f32x4*)(cwS + (part * 4 + j) * 128 + 16 * cgp);
                                    const f32x4 w0 = wv[0], w1 = wv[1], w2 = wv[2], w3 = wv[3];
                                    y[0] += w0.x * bf_lo(x0.x); y[1] += w0.y * bf_hi(x0.x); y[2] += w0.z * bf_lo(x0.y); y[3] += w0.w * bf_hi(x0.y);
                                    y[4] += w1.x * bf_lo(x0.z); y[5] += w1.y * bf_hi(x0.z); y[6] += w1.z * bf_lo(x0.w); y[7] += w1.w * bf_hi(x0.w);
                                    y[8] += w2.x * bf_lo(x1.x); y[9] += w2.y * bf_hi(x1.x); y[10] += w2.z * bf_lo(x1.y); y[11] += w2.w * bf_hi(x1.y);
                                    y[12] += w3.x * bf_lo(x1.z); y[13] += w3.y * bf_hi(x1.z); y[14] += w3.z * bf_lo(x1.w); y[15] += w3.w * bf_hi(x1.w);
                                }
                            }
#pragma unroll
                            for (int i = 0; i < 16; ++i) y[i] = pg8::silu_f(y[i]);
                            if (part < 2) {
                                float ss = 0.f;
#pragma unroll
                                for (int i = 0; i < 16; ++i) ss += y[i] * y[i];
                                ss += __shfl_xor(ss, 1); ss += __shfl_xor(ss, 2); ss += __shfl_xor(ss, 4);
                                const float rinv = rsqrtf(ss + EPS) * (part == 0 ? 0.08838834764831845f : 1.f);
#pragma unroll
                                for (int i = 0; i < 16; ++i) y[i] *= rinv;
                            }
                            if (part == 0) {
                                u32x4 a0, a1;
                                a0.x = pk2(y[0], y[1]); a0.y = pk2(y[2], y[3]); a0.z = pk2(y[4], y[5]); a0.w = pk2(y[6], y[7]);
                                a1.x = pk2(y[8], y[9]); a1.y = pk2(y[10], y[11]); a1.z = pk2(y[12], y[13]); a1.w = pk2(y[14], y[15]);
                                *(LAS u32x4*)(qs + tk * 136 + 16 * cgp) = a0; *(LAS u32x4*)(qs + tk * 136 + 16 * cgp + 8) = a1;
                                u32x4 e0, e1;
                                e0.x = pk2(y[0] * eg, y[1] * eg); e0.y = pk2(y[2] * eg, y[3] * eg); e0.z = pk2(y[8] * eg, y[9] * eg); e0.w = pk2(y[10] * eg, y[11] * eg);
                                e1.x = pk2(y[4] * eg, y[5] * eg); e1.y = pk2(y[6] * eg, y[7] * eg); e1.z = pk2(y[12] * eg, y[13] * eg); e1.w = pk2(y[14] * eg, y[15] * eg);
                                u32x4* dst = (u32x4*)(rec + RO_QE + (tk * 136 + 16 * cgp) * 2); dst[0] = e0; dst[1] = e1;
                            } else if (part == 1) {
                                u32x4 a0, a1;
                                a0.x = pk2(y[0], y[1]); a0.y = pk2(y[2], y[3]); a0.z = pk2(y[4], y[5]); a0.w = pk2(y[6], y[7]);
                                a1.x = pk2(y[8], y[9]); a1.y = pk2(y[10], y[11]); a1.z = pk2(y[12], y[13]); a1.w = pk2(y[14], y[15]);
                                *(LAS u32x4*)(ks + tk * 136 + 16 * cgp) = a0; *(LAS u32x4*)(ks + tk * 136 + 16 * cgp + 8) = a1;
                                const float be = btv * eg;
#pragma unroll
                                for (int i = 0; i < 16; ++i) { kdT[(16 * cgp + i) * 72 + tkpx] = (bf16)f2bf(y[i] * egl); kbeT[(16 * cgp + i) * 72 + tkx] = (bf16)f2bf(y[i] * be); }
                            } else {
#pragma unroll
                                for (int i = 0; i < 16; ++i) vbT[(16 * cgp + i) * 72 + tkx] = (bf16)f2bf(y[i] * btv);
                            }
                        }
                    }
                    WG_BAR();
                    for (int rc_ = 0; rc_ < REP_SC; ++rc_) {
                        const int mat = wave >> 2, rt = (wave >> 1) & 1, ct = wave & 1;
                        f32x16 acc;
#pragma unroll
                        for (int i = 0; i < 16; ++i) acc[i] = 0.f;
                        if (!(rt == 0 && ct == 1)) {
                            const LAS bf16* Ab = (mat ? qs : ks) + (32 * rt + r32h) * 136 + 8 * hhh;
                            const LAS bf16* Bb = ks + (32 * ct + r32h) * 136 + 8 * hhh;
#pragma unroll
                            for (int s = 0; s < 8; ++s) { const bf16x8 a = *(const LAS bf16x8*)(Ab + 16 * s); const bf16x8 bb = *(const LAS bf16x8*)(Bb + 16 * s); acc = MFMA32(a, bb, acc); }
                        }
                        const int sc = 32 * ct + r32h; const float gs = gcS[h * 64 + sc];
                        const int scp = (sc & ~15) | swap23(sc & 15);
                        bf16* attn = (bf16*)(rec + RO_ATTN);
#pragma unroll
                        for (int g = 0; g < 4; ++g) {
                            const int cb = 32 * rt + 8 * g + 4 * hhh;
                            const f32x4 gcv = *(const LAS f32x4*)(gcS + h * 64 + cb), btv = *(const LAS f32x4*)(betaS + h * 64 + cb);
                            f32x4 lv4;
#pragma unroll
                            for (int e = 0; e < 4; ++e) { const int c = cb + e; const int i = 4 * g + e;
                                const float d = (sc <= c) ? __expf(gcv[e] - gs) : 0.f;
                                if (mat == 0) { const float lv = (sc < c) ? btv[e] * acc[i] * d : 0.f; Lf[c * 68 + sc] = lv; lv4[e] = lv; }
                                else attn[c * 72 + scp] = (bf16)f2bf(acc[i] * d); }
                            if (mat == 0) *(LAS f32x4*)(LfT + sc * 68 + cb) = lv4;
                        }
                    }
                    WG_BAR();
                    f32x16 Yacc;
#pragma unroll
                    for (int i = 0; i < 16; ++i) Yacc[i] = 0.f;
                    for (int rd_ = 0; rd_ < REP_SD; ++rd_)
                    if (wave < 2) {
                        const int blk = wave, col = laneh & 31;
                        float t[32];
                        const LAS float* Lfv = Lf + (32 * blk) * 68 + 32 * blk + col; asm volatile("" : "+v"(Lfv));
                        const LAS float* LTv = LfT + (32 * blk) * 68 + 32 * blk; asm volatile("" : "+v"(LTv));
                        t[0] = 0.f;
#pragma unroll
                        for (int c = 1; c < 32; ++c) t[c] = -Lfv[c * 68];
#define SUB_LOAD(buf, s) do { _Pragma("unroll") for (int g_ = ((s) + 1) >> 2; g_ < 8; ++g_) buf[g_] = *(const LAS f32x4*)(LTv + (s) * 68 + 4 * g_); } while (0)
#define SUB_FMA(buf, s) do { const float xs_ = t[s]; _Pragma("unroll") for (int g_ = ((s) + 1) >> 2; g_ < 8; ++g_) { \
        if (4 * g_ > (s)) t[4 * g_] -= buf[g_][0] * xs_; if (4 * g_ + 1 > (s)) t[4 * g_ + 1] -= buf[g_][1] * xs_; \
        if (4 * g_ + 2 > (s)) t[4 * g_ + 2] -= buf[g_][2] * xs_; if (4 * g_ + 3 > (s)) t[4 * g_ + 3] -= buf[g_][3] * xs_; } } while (0)
                        f32x4 la[8], lb[8];
                        SUB_LOAD(la, 1);
#pragma unroll
                        for (int s = 1; s < 31; s += 2) {
                            SUB_LOAD(lb, s + 1); __builtin_amdgcn_sched_barrier(0);
                            SUB_FMA(la, s); __builtin_amdgcn_sched_barrier(0);
                            if (s + 2 < 31) SUB_LOAD(la, s + 2);
                            __builtin_amdgcn_sched_barrier(0);
                            SUB_FMA(lb, s + 1); __builtin_amdgcn_sched_barrier(0);
                        }
#undef SUB_LOAD
#undef SUB_FMA
#pragma unroll
                        for (int c = 0; c < 32; ++c) Ts[(32 * blk + c) * 72 + 32 * blk + col] = (bf16)f2bf(t[c]);
                        asm volatile("s_waitcnt lgkmcnt(0)" ::: "memory");
                        Ts[(32 * blk + col) * 72 + 32 * blk + col] = (bf16)0x3F80;
                        if (blk == 0) {
#pragma unroll
                            for (int i = 0; i < 16; ++i) Yacc[i] = 0.f;
#pragma unroll
                            for (int kk = 0; kk < 2; ++kk) {
                                const LAS float* ap = Lf + (32 + r32h) * 68 + 16 * kk + 8 * hhh;
                                const f32x4 a0 = *(const LAS f32x4*)ap, a1 = *(const LAS f32x4*)(ap + 4);
                                u32x4 aw; aw.x = pk2(a0[0], a0[1]); aw.y = pk2(a0[2], a0[3]); aw.z = pk2(a1[0], a1[1]); aw.w = pk2(a1[2], a1[3]);
                                float bv[8];
#pragma unroll
                                for (int j = 0; j < 8; ++j) { float lo = t[16 * kk + j], hi = t[16 * kk + 8 + j]; asm volatile("" : "+v"(lo), "+v"(hi));
                                    const int rowk = 16 * kk + 8 * hhh + j; bv[j] = (hhh ? hi : lo) + ((rowk == col) ? 1.f : 0.f); }
                                u32x4 bw; bw.x = pk2(bv[0], bv[1]); bw.y = pk2(bv[2], bv[3]); bw.z = pk2(bv[4], bv[5]); bw.w = pk2(bv[6], bv[7]);
                                Yacc = MFMA32(__builtin_bit_cast(bf16x8, aw), __builtin_bit_cast(bf16x8, bw), Yacc);
                            }
                        }
                    } else {
                        for (int p = tidh - 128; p < 1152; p += NTHREADS - 128) *(u32x4*)(rec + RO_KDT + 16 * p) = *(const LAS u32x4*)((LAS unsigned char*)kdT + 16 * p);
                    }
                    WG_BAR();
                    if (wave == 0) {
                        f32x16 acc2;
#pragma unroll
                        for (int i = 0; i < 16; ++i) acc2[i] = 0.f;
#pragma unroll
                        for (int s = 0; s < 2; ++s) {
                            const LAS bf16* ap = Ts + (32 + r32h) * 72 + 32 + 16 * s + 4 * hhh;
                            const u32x2 q0 = *(const LAS u32x2*)ap, q1 = *(const LAS u32x2*)(ap + 8);
                            u32x4 aw; aw.x = q0.x; aw.y = q0.y; aw.z = q1.x; aw.w = q1.y;
                            acc2 = MFMA32(__builtin_bit_cast(bf16x8, aw), pack_step(Yacc, s), acc2);
                        }
#pragma unroll
                        for (int i = 0; i < 16; ++i) Ts[(32 + crow(i, hhh)) * 72 + r32h] = (bf16)f2bf(-acc2[i]);
                    }
                    WG_BAR();
                    for (int re_ = 0; re_ < REP_SE; ++re_) {
                        const int mat = wave >> 2, ct = wave & 3;
                        const LAS bf16* Bsrc = (mat ? kbeT : vbT) + (32 * ct + r32h) * 72 + 8 * (hhh ^ (r32h >> 4));
#pragma unroll
                        for (int rt = 0; rt < 2; ++rt) {
                            f32x16 acc;
#pragma unroll
                            for (int i = 0; i < 16; ++i) acc[i] = 0.f;
#pragma unroll
                            for (int s = 0; s < 4; ++s) if (s < 2 * (rt + 1)) { const bf16x8 a = *(const LAS bf16x8*)(Ts + (32 * rt + r32h) * 72 + 16 * s + 8 * hhh); const bf16x8 bb = *(const LAS bf16x8*)(Bsrc + 16 * (s ^ ct)); acc = MFMA32(a, bb, acc); }
                            if (mat == 0) { u32x4* up = (u32x4*)UB + (((size_t)item * 4 + ct) * 2 + rt) * 128 + laneh;
#pragma unroll
                                for (int q = 0; q < 2; ++q) { u32x4 w; w.x = pk2(acc[8 * q], acc[8 * q + 1]); w.y = pk2(acc[8 * q + 2], acc[8 * q + 3]); w.z = pk2(acc[8 * q + 4], acc[8 * q + 5]); w.w = pk2(acc[8 * q + 6], acc[8 * q + 7]); up[q * 64] = w; }
                            } else { bf16* nw = (bf16*)(rec + RO_NEGW); const int d = 32 * ct + r32h; const int dp = (d & ~15) | swap23(d & 15);
#pragma unroll
                                for (int i = 0; i < 16; ++i) nw[(32 * rt + crow(i, hhh)) * 136 + dp] = (bf16)f2bf(-acc[i]);
                            }
                        }
                        if (tidh == 0) GL[item] = __expf(gcS[h * 64 + 63]);
                    }
                    WG_BAR();
                }
            }
        }
        }
#endif
        for (int rs_ = 0; rs_ < REP_SYNC; ++rs_) xcd_barrier(xbar);

#ifndef SKIP_P4
        for (int rep_ = 0; rep_ < REP_P4; ++rep_)
        {
        {
            PH_BEGIN
            const float* pool_w = P.in[8] + Lq * 4 * 64 * 64; const float* pool_scale = P.in[9] + Lq * 256; const float* sconv_w = P.in[10] + Lq * 3 * 256;
            const int nscan = NB * 4;
#ifndef SKIP_SCAN
            for (int rsc_ = 0; rsc_ < REP_SCAN; ++rsc_)
            if (bid < nscan || G <= nscan) {
                for (int bh = bid; bh < nscan; bh += G) {
                    const int b = bh >> 2, h = bh & 3;
                    const unsigned char* rec0 = REC + (size_t)(bh * 32) * REC_BYTES;
                    for (int p = tid; p < REC_BYTES / 16; p += NTHREADS) *(LAS u32x4*)(lds + 16 * p) = *(const u32x4*)(rec0 + 16 * p);
                    WG_BAR();
                    f32x16 S[4];
#pragma unroll
                    for (int t = 0; t < 4; ++t)
#pragma unroll
                        for (int i = 0; i < 16; ++i) S[t][i] = 0.f;
                    if (wave >= 4) {
                        const int t2 = tid - 256; const int fo = (t2 >> 4) * 4096 + (t2 & 15) * 16;
                        const unsigned char* rg = rec0 + fo; LAS unsigned char* l0 = lds + fo;
                        u32x4 RA[16], RB[16], RC[16];
#define SC_LD(R, k) do { const int k_ = ((k) < 32) ? (k) : 31; const unsigned char* rn_ = rg + (size_t)k_ * REC_BYTES; _Pragma("unroll") for (int i = 0; i < 16; ++i) R[i] = *(const u32x4*)(rn_ + 256 * i); } while (0)
#define SC_ST(R, k) do { LAS unsigned char* ln_ = l0 + ((k) & 1) * REC_BYTES; _Pragma("unroll") for (int i = 0; i < 16; ++i) { if (fo + 256 * i < REC_BYTES) *(LAS u32x4*)(ln_ + 256 * i) = R[i]; } } while (0)
                        SC_LD(RA, 1); SC_LD(RB, 2);
                        for (int n = 0; n < 30; n += 3) {
                            SC_LD(RC, n + 3); SC_ST(RA, n + 1); WG_BAR();
                            SC_LD(RA, n + 4); SC_ST(RB, n + 2); WG_BAR();
                            SC_LD(RB, n + 5); SC_ST(RC, n + 3); WG_BAR();
                        }
                        SC_ST(RA, 31); WG_BAR();
                        WG_BAR();
#undef SC_LD
#undef SC_ST
                    } else {
                        const int ct = wave;
                        f32x16 avn[2];
                        const float decall = GL[bh * 32 + (lane & 31)];
                        { const u32x4* up = (const u32x4*)UB + (((size_t)(bh * 32) * 4 + ct) * 2) * 128 + lane;
#pragma unroll
                          for (int rt = 0; rt < 2; ++rt)
#pragma unroll
                            for (int q = 0; q < 2; ++q) { const u32x4 v = up[rt * 128 + q * 64]; avn[rt][8 * q] = bf_lo(v.x); avn[rt][8 * q + 1] = bf_hi(v.x); avn[rt][8 * q + 2] = bf_lo(v.y); avn[rt][8 * q + 3] = bf_hi(v.y); avn[rt][8 * q + 4] = bf_lo(v.z); avn[rt][8 * q + 5] = bf_hi(v.z); avn[rt][8 * q + 6] = bf_lo(v.w); avn[rt][8 * q + 7] = bf_hi(v.w); }
                        }
                        for (int n = 0; n < 32; ++n) {
                            LAS unsigned char* cur = lds + (n & 1) * REC_BYTES;
                            f32x16 av[2], ao[2];
#pragma unroll
                            for (int rt = 0; rt < 2; ++rt)
#pragma unroll
                                for (int i = 0; i < 16; ++i) { av[rt][i] = avn[rt][i]; ao[rt][i] = 0.f; }
                            const float dec = __int_as_float(__builtin_amdgcn_readlane(__float_as_int(decall), n));
                            { const int nn = (n < 31) ? n + 1 : 31;
                              const u32x4* up = (const u32x4*)UB + (((size_t)(bh * 32 + nn) * 4 + ct) * 2) * 128 + lane;
#pragma unroll
                              for (int rt = 0; rt < 2; ++rt)
#pragma unroll
                                for (int q = 0; q < 2; ++q) { const u32x4 v = up[rt * 128 + q * 64]; avn[rt][8 * q] = bf_lo(v.x); avn[rt][8 * q + 1] = bf_hi(v.x); avn[rt][8 * q + 2] = bf_lo(v.y); avn[rt][8 * q + 3] = bf_hi(v.y); avn[rt][8 * q + 4] = bf_lo(v.z); avn[rt][8 * q + 5] = bf_hi(v.z); avn[rt][8 * q + 6] = bf_lo(v.w); avn[rt][8 * q + 7] = bf_hi(v.w); }
                            }
                            const LAS bf16* fA = (const LAS bf16*)(cur + RO_NEGW) + r32 * 136 + 8 * hh;
                            const LAS bf16* fK = (const LAS bf16*)(cur + RO_KDT) + r32 * 72 + 8 * (hh ^ (r32 >> 4));
                            const LAS bf16* fT = (const LAS bf16*)(cur + RO_ATTN) + r32 * 72 + 8 * hh;
#define SC_LDF(f, kk) do { f[0] = *(const LAS bf16x8*)(fA + 16 * (kk)); f[1] = *(const LAS bf16x8*)(fA + 32 * 136 + 16 * (kk)); \
                           f[2] = *(const LAS bf16x8*)(fA + RO_QE / 2 + 16 * (kk)); f[3] = *(const LAS bf16x8*)(fA + RO_QE / 2 + 32 * 136 + 16 * (kk)); } while (0)
#define SC_MM(f, kk) do { const bf16x8 sb_ = pack_step(S[(kk) >> 1], (kk) & 1); \
                          av[0] = MFMA32(f[0], sb_, av[0]); av[1] = MFMA32(f[1], sb_, av[1]); ao[0] = MFMA32(f[2], sb_, ao[0]); ao[1] = MFMA32(f[3], sb_, ao[1]); } while (0)
                            bf16x8 fa[4], fb[4], ft[6];
                            __builtin_amdgcn_sched_barrier(0);
                            SC_LDF(fa, 0);
#pragma unroll
                            for (int kk = 0; kk < 8; kk += 2) {
                                SC_LDF(fb, kk + 1); __builtin_amdgcn_sched_barrier(0);
                                SC_MM(fa, kk); __builtin_amdgcn_sched_barrier(0);
                                if (kk + 2 < 8) SC_LDF(fa, kk + 2);
                                else { ft[0] = *(const LAS bf16x8*)(fT); ft[1] = *(const LAS bf16x8*)(fT + 16); ft[2] = *(const LAS bf16x8*)(fT + 32 * 72);
                                       ft[3] = *(const LAS bf16x8*)(fT + 32 * 72 + 16); ft[4] = *(const LAS bf16x8*)(fT + 32 * 72 + 32); ft[5] = *(const LAS bf16x8*)(fT + 32 * 72 + 48); }
                                __builtin_amdgcn_sched_barrier(0);
                                SC_MM(fb, kk + 1); __builtin_amdgcn_sched_barrier(0);
                            }
#undef SC_LDF
#undef SC_MM
                            bf16x8 vb[4];
#pragma unroll
                            for (int rt = 0; rt < 2; ++rt) { vb[2 * rt] = pack_step(av[rt], 0); vb[2 * rt + 1] = pack_step(av[rt], 1); }
#define SC_LDK(f, t) do { f[0] = *(const LAS bf16x8*)(fK + (32 * (t)) * 72 + 16 * (0 ^ (t))); f[1] = *(const LAS bf16x8*)(fK + (32 * (t)) * 72 + 16 * (1 ^ (t))); \
                           f[2] = *(const LAS bf16x8*)(fK + (32 * (t)) * 72 + 16 * (2 ^ (t))); f[3] = *(const LAS bf16x8*)(fK + (32 * (t)) * 72 + 16 * (3 ^ (t))); } while (0)
#define SC_MK(f, t) do { _Pragma("unroll") for (int i = 0; i < 16; ++i) S[t][i] *= dec; \
                          S[t] = MFMA32(f[0], vb[0], S[t]); S[t] = MFMA32(f[1], vb[1], S[t]); S[t] = MFMA32(f[2], vb[2], S[t]); S[t] = MFMA32(f[3], vb[3], S[t]); } while (0)
                            SC_LDK(fa, 0);
                            __builtin_amdgcn_sched_barrier(0);
                            ao[0] = MFMA32(ft[0], vb[0], ao[0]); ao[0] = MFMA32(ft[1], vb[1], ao[0]);
                            ao[1] = MFMA32(ft[2], vb[0], ao[1]); ao[1] = MFMA32(ft[3], vb[1], ao[1]); ao[1] = MFMA32(ft[4], vb[2], ao[1]); ao[1] = MFMA32(ft[5], vb[3], ao[1]);
                            __builtin_amdgcn_sched_barrier(0);
                            SC_LDK(fb, 1); __builtin_amdgcn_sched_barrier(0);
                            SC_MK(fa, 0); __builtin_amdgcn_sched_barrier(0);
                            SC_LDK(fa, 2); __builtin_amdgcn_sched_barrier(0);
                            SC_MK(fb, 1); __builtin_amdgcn_sched_barrier(0);
                            SC_LDK(fb, 3); __builtin_amdgcn_sched_barrier(0);
                            SC_MK(fa, 2); __builtin_amdgcn_sched_barrier(0);
                            {
                                unsigned char* obase = (unsigned char*)(OB + ((size_t)b * SEQ + 64 * n) * 512 + h * 128);
                                unsigned off0 = (unsigned)((4 * hh * 512 + 32 * ct + r32) * 4); asm volatile("" : "+v"(off0));
#pragma unroll
                                for (int rt = 0; rt < 2; ++rt)
#pragma unroll
                                    for (int i = 0; i < 16; ++i) *(float*)(obase + (off0 + (unsigned)((32 * rt + (i & 3) + 8 * (i >> 2)) * 2048))) = ao[rt][i];
                            }
                            __builtin_amdgcn_sched_barrier(0);
                            SC_MK(fb, 3); __builtin_amdgcn_sched_barrier(0);
#undef SC_LDK
#undef SC_MK
                            WG_BAR();
                        }
                    }
                    WG_BAR();
                }
            }
#endif
#ifndef SKIP_MIX
            for (int rmx_ = 0; rmx_ < REP_MIX; ++rmx_)
            {
                const int nmix = (G > nscan) ? G - nscan : G; const int mixid = (G > nscan) ? bid - nscan : bid;
                if (mixid >= 0) {
                    LAS bf16* pooledS = (LAS bf16*)(lds + 0);
                    LAS bf16* WTs = (LAS bf16*)(lds + 33792);
                    for (int i = tid; i < 4 * 64 * 64; i += NTHREADS) { const int g = i >> 12, c = (i >> 6) & 63, d = i & 63; WTs[(g * 64 + d) * 72 + c] = (bf16)f2bf(pool_w[i]); }
                    for (int unit = mixid; unit < M / 64; unit += nmix) {
                        const size_t urow0 = (size_t)unit * 64; const int t0 = (int)(urow0 % SEQ);
                        const int tk = tid >> 3, sub = tid & 7; const int t = t0 + tk; const size_t row = urow0 + tk;
                        WG_BAR();
                        {
                            LAS bf16* poolS = (LAS bf16*)(lds + 70656);
                            for (int p = tid; p < 79 * 32; p += NTHREADS) { const int rr = p >> 5, cc = p & 31; const int tt = t0 - 15 + rr;
                                u32x4 v = {0u, 0u, 0u, 0u}; if (tt >= 0) v = *(const u32x4*)(PB + (urow0 - 15 + rr) * PHALF + 512 + 8 * cc);
                                *(LAS u32x4*)(poolS + rr * 264 + 8 * cc) = v; }
                            WG_BAR();
                            const int win = 2 << (sub >> 1);
                            float sum[32];
#pragma unroll
                            for (int i = 0; i < 32; ++i) sum[i] = 0.f;
                            for (int j = 0; j < win; ++j) {
                                const LAS u32x4* src = (const LAS u32x4*)(poolS + (tk + 15 - j) * 264 + 32 * sub);
#pragma unroll
                                for (int q = 0; q < 4; ++q) { const u32x4 xv = src[q];
                                    sum[8 * q + 0] += bf_lo(xv.x); sum[8 * q + 1] += bf_hi(xv.x); sum[8 * q + 2] += bf_lo(xv.y); sum[8 * q + 3] += bf_hi(xv.y);
                                    sum[8 * q + 4] += bf_lo(xv.z); sum[8 * q + 5] += bf_hi(xv.z); sum[8 * q + 6] += bf_lo(xv.w); sum[8 * q + 7] += bf_hi(xv.w); }
                            }
                            const float inv = 1.f / (float)((t + 1 < win) ? (t + 1) : win);
#pragma unroll
                            for (int q = 0; q < 4; ++q) { u32x4 w; const u32x4 sv = ((const LAS u32x4*)(poolS + (tk + 15) * 264 + 32 * sub))[q];
                                w.x = pk2(sum[8 * q + 0] * inv - bf_lo(sv.x), sum[8 * q + 1] * inv - bf_hi(sv.x)); w.y = pk2(sum[8 * q + 2] * inv - bf_lo(sv.y), sum[8 * q + 3] * inv - bf_hi(sv.y));
                                w.z = pk2(sum[8 * q + 4] * inv - bf_lo(sv.z), sum[8 * q + 5] * inv - bf_hi(sv.z)); w.w = pk2(sum[8 * q + 6] * inv - bf_lo(sv.w), sum[8 * q + 7] * inv - bf_hi(sv.w));
                                *(LAS u32x4*)(pooledS + tk * 264 + 32 * sub + 8 * q) = w; }
                        }
                        {
                            float acc[32];
#pragma unroll
                            for (int i = 0; i < 32; ++i) acc[i] = 0.f;
#pragma unroll
                            for (int j = 0; j < 3; ++j) {
                                if (t - 2 + j >= 0) {
                                    const u32x4* sc = (const u32x4*)(PB + (row - 2 + j) * PHALF + 1024 + 32 * sub); const u32x4* sh = (const u32x4*)(PB + (row - 2 + j) * PHALF + 1280 + 32 * sub);
                                    const f32x4* wv = (const f32x4*)(sconv_w + j * 256 + 32 * sub);
#pragma unroll
                                    for (int q = 0; q < 4; ++q) { const u32x4 c4 = sc[q], h4 = sh[q]; const f32x4 w0 = wv[2 * q], w1 = wv[2 * q + 1];
                                        acc[8 * q + 0] += w0.x * bf_lo(c4.x) * bf_lo(h4.x); acc[8 * q + 1] += w0.y * bf_hi(c4.x) * bf_hi(h4.x); acc[8 * q + 2] += w0.z * bf_lo(c4.y) * bf_lo(h4.y); acc[8 * q + 3] += w0.w * bf_hi(c4.y) * bf_hi(h4.y);
                                        acc[8 * q + 4] += w1.x * bf_lo(c4.z) * bf_lo(h4.z); acc[8 * q + 5] += w1.y * bf_hi(c4.z) * bf_hi(h4.z); acc[8 * q + 6] += w1.z * bf_lo(c4.w) * bf_lo(h4.w); acc[8 * q + 7] += w1.w * bf_hi(c4.w) * bf_hi(h4.w); }
                                }
                            }
                            const u32x4* sb = (const u32x4*)(PB + row * PHALF + 768 + 32 * sub);
                            u32x4* dst = (u32x4*)(HB + row * DM + 768 + 32 * sub);
#pragma unroll
                            for (int q = 0; q < 4; ++q) { const u32x4 b4 = sb[q]; u32x4 w;
                                w.x = pk2(acc[8 * q + 0] * bf_lo(b4.x), acc[8 * q + 1] * bf_hi(b4.x)); w.y = pk2(acc[8 * q + 2] * bf_lo(b4.y), acc[8 * q + 3] * bf_hi(b4.y));
                                w.z = pk2(acc[8 * q + 4] * bf_lo(b4.z), acc[8 * q + 5] * bf_hi(b4.z)); w.w = pk2(acc[8 * q + 6] * bf_lo(b4.w), acc[8 * q + 7] * bf_hi(b4.w));
                                dst[q] = w; }
                        }
                        WG_BAR();
                        {
                            const int g = wave >> 1, rt = wave & 1;
#pragma unroll
                            for (int ct = 0; ct < 2; ++ct) {
                                f32x16 acc;
#pragma unroll
                                for (int i = 0; i < 16; ++i) acc[i] = 0.f;
#pragma unroll
                                for (int s = 0; s < 4; ++s) { const bf16x8 a = *(const LAS bf16x8*)(pooledS + (32 * rt + r32) * 264 + 64 * g + 16 * s + 8 * hh);
                                    const bf16x8 bb = *(const LAS bf16x8*)(WTs + (g * 64 + 32 * ct + r32) * 72 + 16 * s + 8 * hh); acc = MFMA32(a, bb, acc); }
                                const int d = 64 * g + 32 * ct + r32; const float psc = pool_scale[d];
#pragma unroll
                                for (int i = 0; i < 16; ++i) HB[(urow0 + 32 * rt + crow(i, hh)) * DM + 512 + d] = (bf16)f2bf(acc[i] * psc);
                            }
                        }
                    }
                    {
                        WG_BAR();
                        const float* w_out = P.in[11] + (size_t)Lq * DM * DM;
                        const float* w_gate = P.in[13] + (size_t)Lq * DM * DFF; const float* w_up = P.in[14] + (size_t)Lq * DM * DFF; const float* w_down = P.in[15] + (size_t)Lq * DFF * DM;
                        const float* ple_proj = P.in[16] + (size_t)Lq * PLE * DM; const float* ple_gate = P.in[17] + (size_t)Lq * DM * DM;
                        LAS float* scr = (LAS float*)(lds + wave * 8448);
                        constexpr int I_OUT = 16 * 32, I_GU = 16 * 176, I_DOWN = 44 * 32, I_PG = 16 * 32, I_PP = 4 * 32;
                        constexpr int NITEMS = I_OUT + I_GU + I_DOWN + I_PG + I_PP;
                        const int nextra = (M / 64 > nmix && M / 64 - nmix < nmix) ? (M / 64 - nmix) : 0; const int nconv = nmix - nextra, convid = mixid - nextra;
                        if (convid >= 0)
                        for (int it = convid * NWAVES + wave; it < NITEMS; it += nconv * NWAVES) {
                            int r = it;
                            if (r < I_OUT) { const int kb = r / 32, nb = r % 32; transpose_item(w_out, DM, 64 * kb, 32 * nb, Wout_t, DM, 32 * nb, scr, lane); continue; } r -= I_OUT;
                            if (r < I_GU) { const int kb = r / 176, nb = r % 176; const int pn = nb >> 3, wi = nb & 7; const float* src = (wi < 4) ? w_gate : w_up;
                                transpose_item(src, DFF, 64 * kb, 128 * pn + 32 * (wi & 3), Wgu_t, DM, 32 * nb, scr, lane); continue; } r -= I_GU;
                            if (r < I_DOWN) { const int kb = r / 32, nb = r % 32; transpose_item(w_down, DM, 64 * kb, 32 * nb, Wdown_t, DFF, 32 * nb, scr, lane); continue; } r -= I_DOWN;
                            if (r < I_PG) { const int kb = r / 32, nb = r % 32; transpose_item(ple_gate, DM, 64 * kb, 32 * nb, Wpg_t, DM, 32 * nb, scr, lane); continue; } r -= I_PG;
                            { const int kb = r / 32, nb = r % 32; transpose_item(ple_proj, DM, 64 * kb, 32 * nb, Wpp_t, PLE, 32 * nb, scr, lane); }
                        }
                    }
                }
            }
#endif
        }
        }
#endif
        for (int rs_ = 0; rs_ < REP_SYNC; ++rs_) xcd_barrier(xbar);

#ifndef SKIP_P5
        for (int rep_ = 0; rep_ < REP_P5; ++rep_)
        {
        {
        PH_BEGIN
        const float* onorm_g = P.in[7] + Lq * 128; const float* p_in = P.in[1] + (size_t)Lq * M * PLE;
        if (Lq + 1 < DEPTH) {
            const float* w_in_n = P.in[3] + (size_t)(Lq + 1) * DM * DIN; LAS float* scr = (LAS float*)(lds + wave * 8448);
            for (int it = gw; it < 16 * 96; it += NGW) { const int kb = it / 96, nb = it % 96; const int d0 = 32 * nb; transpose_item(w_in_n, DIN, 64 * kb, d0 < 2048 ? d0 : d0 + 8, Win_t, DM, d0, scr, lane); }
            for (int i = gt; i < 8 * DM; i += NGT) { const int n = i >> 10, k = i & 1023; Wab_t[n * DM + k] = (bf16)f2bf(w_in_n[(size_t)k * DIN + 2048 + n]); }
        }
        for (int i = gt; i < M * PLE / 8; i += NGT) { const f32x4 a = ((const f32x4*)p_in)[2 * i], c = ((const f32x4*)p_in)[2 * i + 1]; ((u32x4*)PBF)[i] = pg8::pack8(a, c); }
        for (int idx = gt; idx < M * 32; idx += NGT) {
            const int row = idx >> 5, h = (idx >> 3) & 3, cgp = idx & 7;
            const f32x4* op = (const f32x4*)(OB + (size_t)row * 512 + h * 128 + 16 * cgp);
            const f32x4 o0 = op[0], o1 = op[1], o2 = op[2], o3 = op[3];
            float ss = (o0.x * o0.x + o0.y * o0.y + o0.z * o0.z + o0.w * o0.w) + (o1.x * o1.x + o1.y * o1.y + o1.z * o1.z + o1.w * o1.w)
                     + (o2.x * o2.x + o2.y * o2.y + o2.z * o2.z + o2.w * o2.w) + (o3.x * o3.x + o3.y * o3.y + o3.z * o3.z + o3.w * o3.w);
            ss += __shfl_xor(ss, 1); ss += __shfl_xor(ss, 2); ss += __shfl_xor(ss, 4);
            const float rstd = rsqrtf(ss * (1.f / 128.f) + EPS);
            const u32x4* zp = (const u32x4*)(PB + (size_t)row * PHALF + h * 128 + 16 * cgp); const u32x4 z0 = zp[0], z1 = zp[1];
            const f32x4* gp = (const f32x4*)(onorm_g + 16 * cgp); const f32x4 g0 = gp[0], g1 = gp[1], g2 = gp[2], g3 = gp[3];
            u32x4 w0, w1;
            w0.x = pk2(o0.x * rstd * g0.x * pg8::silu_f(bf_lo(z0.x)), o0.y * rstd * g0.y * pg8::silu_f(bf_hi(z0.x))); w0.y = pk2(o0.z * rstd * g0.z * pg8::silu_f(bf_lo(z0.y)), o0.w * rstd * g0.w * pg8::silu_f(bf_hi(z0.y)));
            w0.z = pk2(o1.x * rstd * g1.x * pg8::silu_f(bf_lo(z0.z)), o1.y * rstd * g1.y * pg8::silu_f(bf_hi(z0.z))); w0.w = pk2(o1.z * rstd * g1.z * pg8::silu_f(bf_lo(z0.w)), o1.w * rstd * g1.w * pg8::silu_f(bf_hi(z0.w)));
            w1.x = pk2(o2.x * rstd * g2.x * pg8::silu_f(bf_lo(z1.x)), o2.y * rstd * g2.y * pg8::silu_f(bf_hi(z1.x))); w1.y = pk2(o2.z * rstd * g2.z * pg8::silu_f(bf_lo(z1.y)), o2.w * rstd * g2.w * pg8::silu_f(bf_hi(z1.y)));
            w1.z = pk2(o3.x * rstd * g3.x * pg8::silu_f(bf_lo(z1.z)), o3.y * rstd * g3.y * pg8::silu_f(bf_hi(z1.z))); w1.w = pk2(o3.z * rstd * g3.z * pg8::silu_f(bf_lo(z1.w)), o3.w * rstd * g3.w * pg8::silu_f(bf_hi(z1.w)));
            u32x4* dst = (u32x4*)(HB + (size_t)row * DM + h * 128 + 16 * cgp); dst[0] = w0; dst[1] = w1;
        }
        }
        }
#endif
        for (int rs_ = 0; rs_ < REP_SYNC; ++rs_) xcd_barrier(xbar);

#ifndef SKIP_P6
        {
            PH_BEGIN
            const float* xin = (Lq == 0) ? P.in[0] : XRES;
            pg8::Gemm g{HB, Wout_t, M, DM, DM}; pg8::StaticOrder S; S.init(M, DM, G, bid);
            const float* norm2_g = P.in[12] + Lq * DM;
            pg8::EpiNorm<0> E{xin, XRES, nullptr, XB, norm2_g, XCH(2 * Lq), XCNT(2 * Lq), nullptr};
            pg8::gemm_phase<pg8::EpiNorm<0>, pg8::StaticOrder, false, true>(lds, g, S, E);
        }
#endif
        for (int rs_ = 0; rs_ < REP_SYNC; ++rs_) xcd_barrier(xbar);

#ifndef SKIP_P8
        for (int rep_ = 0; rep_ < REP_P8; ++rep_)
        {
        {
            PH_BEGIN
            { pg8::Gemm g{XB, Wgu_t, M, 2 * DFF, DM}; pg8::StaticOrder S; S.init(M, 2 * DFF, G, bid);
              pg8::EpiSwiglu E{FF, DFF};
              pg8::gemm_phase<pg8::EpiSwiglu, pg8::StaticOrder, true, true>(lds, g, S, E); }
            {
                const int nfull = (64 * 22) % G; const int G2 = (nfull > 0) ? G - nfull : G; const int c2 = (nfull > 0) ? bid - nfull : bid;
                pg8::Gemm g{PBF, Wpp_t, M, DM, PLE}; pg8::StaticOrder S; S.init(M, DM, G2, c2 >= 0 ? c2 : (1 << 28));
                pg8::EpiBf16S E{PP, PP, DM, 1 << 30};
                pg8::gemm_phase<pg8::EpiBf16S, pg8::StaticOrder, true, true>(lds, g, S, E); }
        }
        }
#endif
        for (int rs_ = 0; rs_ < REP_SYNC; ++rs_) xcd_barrier(xbar);

#ifndef SKIP_P9
        {
            { PH_BEGIN
              pg8::Gemm g{FF, Wdown_t, M, DM, DFF}; pg8::StaticOrder S; S.init(M, DM, G, bid);
              pg8::EpiRes E{XRES, nullptr, HB};
              pg8::gemm_phase<pg8::EpiRes, pg8::StaticOrder, ALIGN1, true>(lds, g, S, E); }
        }
#endif
        for (int rs_ = 0; rs_ < REP_SYNC; ++rs_) xcd_barrier(xbar);

#ifndef SKIP_P10
        {
            PH_BEGIN
            pg8::Gemm g{HB, Wpg_t, M, DM, DM}; pg8::StaticOrder S; S.init(M, DM, G, bid);
            if (Lq + 1 < DEPTH) {
                const float* g1n = P.in[2] + (Lq + 1) * DM;
                pg8::EpiNorm<1> E{XRES, XRES, PP, XB, g1n, XCH(2 * Lq + 1), XCNT(2 * Lq + 1), HB};
                pg8::gemm_phase<pg8::EpiNorm<1>, pg8::StaticOrder, false, true>(lds, g, S, E);
            } else {
                pg8::EpiNorm<2> E{XRES, XRES, PP, nullptr, P.in[18], XCH(2 * Lq + 1), XCNT(2 * Lq + 1), HB};
                pg8::gemm_phase<pg8::EpiNorm<2>, pg8::StaticOrder, false, true>(lds, g, S, E);
            }
        }
#endif
        if (L + 1 < DEPTH) { for (int rs_ = 0; rs_ < REP_SYNC; ++rs_) xcd_barrier(xbar); }
    }
}

extern "C" void kernel_launch(void* const* d_in, const int* in_sizes, int n_in, void* d_out, int out_size, void* d_ws, size_t ws_size, hipStream_t stream) {
    static int grid = 0;
    if (grid == 0) {
        if (n_in != 19 || out_size != M * DM || ws_size < WS_END) { fprintf(stderr, "kernel_launch: unexpected shapes (n_in %d out %d ws %zu)\n", n_in, out_size, ws_size); grid = -1; return; }
        int dev = 0, cus = 0, per_cu = 0;
        hipGetDevice(&dev);
        hipDeviceGetAttribute(&cus, hipDeviceAttributeMultiprocessorCount, dev);
        hipFuncSetAttribute((const void*)fwd_kernel, hipFuncAttributeMaxDynamicSharedMemorySize, LDS_BYTES);
        hipOccupancyMaxActiveBlocksPerMultiprocessor(&per_cu, (const void*)fwd_kernel, NTHREADS, LDS_BYTES);
        if (per_cu < 1) { fprintf(stderr, "kernel_launch: occupancy query says %d blocks per CU\n", per_cu); per_cu = 1; }
        if (per_cu > 1) per_cu = 1;
        grid = cus * per_cu;
        if (grid != 256) { fprintf(stderr, "kernel_launch: built for a 256-workgroup grid (one 256x256 unit per workgroup in the fused-norm phases), got %d; nothing launched\n", grid); grid = -1; return; }
        (void)hipGetLastError();
    }
    if (grid < 0) return;
    if (hipMemsetAsync(d_ws, 0, 131072, stream) != hipSuccess) { fprintf(stderr, "kernel_launch: memset of the barrier words failed\n"); return; }
    Params p{};
    for (int i = 0; i < 19; ++i) p.in[i] = (const float*)d_in[i];
    p.out = (float*)d_out; p.ws = (unsigned char*)d_ws;
    void* args[] = {&p};
    hipError_t e = hipLaunchCooperativeKernel((const void*)fwd_kernel, dim3(grid), dim3(NTHREADS), args, LDS_BYTES, stream);
    if (e != hipSuccess) fprintf(stderr, "cooperative launch failed: %s (grid %d)\n", hipGetErrorString(e), grid);
}
```
